# Optimizing an MI355X kernel written in HIP

```python
import math
import numpy as np
import jax
import jax.numpy as jnp
from jax import lax

D_MODEL = 1024
BATCH = 8
SEQ = 4096
DEPTH = 4

GRID_W = 64
CTX_LEN = 256
HEAD_DIM = 64
ROPE_THETA = 10000.0
NORM_EPS = 1e-6
F32 = jnp.float32

A_HEADS = 4
A_QK = HEAD_DIM
A_V = 2 * HEAD_DIM
A_QBLOCK = 128
B_HEADS = 4
B_DK = HEAD_DIM // 2
B_DV = HEAD_DIM
B_GATE_RANK = 16
B_GATE_TAU = 16.0
B_CHUNK = 64
C_HEADS = 4
C_DH = HEAD_DIM
NA_ROWS = 8
NA_COLS = 16

A_WIDTH = A_HEADS * A_V
B_WIDTH = B_HEADS * B_DV
C_WIDTH = C_HEADS * C_DH
MIX_WIDTH = A_WIDTH + B_WIDTH + C_WIDTH

IN_SIZES = (A_HEADS * 2 * A_QK, A_HEADS * 2 * A_QK, A_WIDTH,
            B_HEADS * B_DK, B_HEADS * B_DK, B_WIDTH, B_WIDTH, 2 * B_GATE_RANK,
            C_WIDTH, C_WIDTH, C_WIDTH)
IN_WIDTH = sum(IN_SIZES)

N_GROUPS = 4
EXPERTS_PER_GROUP = 8
N_EXPERTS = N_GROUPS * EXPERTS_PER_GROUP
TOP_K = 2
EXPERT_HIDDEN = 512
MOE_BLOCK = 128

kernel_name = 'hybrid_prefix_diffusion_trunk'


def rms_norm(x, g):
    xf = x.astype(F32)
    y = xf * lax.rsqrt(jnp.mean(xf * xf, axis=-1, keepdims=True) + NORM_EPS)
    return (y * g.astype(F32)).astype(x.dtype)


def split_in(p):
    return jnp.split(p, np.cumsum(IN_SIZES)[:-1].tolist(), axis=-1)


def axial_rope_tables(n_tokens, dtype):
    t = jnp.arange(n_tokens)
    row = (t // GRID_W).astype(F32)
    col = (t % GRID_W).astype(F32)
    n_freq = HEAD_DIM // 4
    inv = ROPE_THETA ** (-jnp.arange(n_freq, dtype=F32) / n_freq)
    ang_r = row[:, None] * inv
    ang_c = col[:, None] * inv
    return (jnp.cos(ang_r).astype(dtype), jnp.sin(ang_r).astype(dtype),
            jnp.cos(ang_c).astype(dtype), jnp.sin(ang_c).astype(dtype))


def apply_axial_rope(x, tabs):
    cr, sr, cc, sc = (tb.reshape((tb.shape[0],) + (1,) * (x.ndim - 3) + (tb.shape[1],)) for tb in tabs)
    x1, x2, x3, x4 = jnp.split(x, 4, axis=-1)
    return jnp.concatenate([x1 * cr - x2 * sr, x2 * cr + x1 * sr,
                            x3 * cc - x4 * sc, x4 * cc + x3 * sc], axis=-1)


def diff_attention(q, k, v, qc, kc, vc, lam, lam_init, g_sub, need_ctx):
    B_, S = q.shape[:2]
    L = qc.shape[1]
    scale = A_QK ** -0.5
    k_all = jnp.concatenate([kc, k], axis=1)
    v_all = jnp.concatenate([vc, v], axis=1)

    def attend(qb, kb, vb):
        s = jnp.einsum('bqhmd,bkhmd->bhmqk', qb, kb).astype(F32) * scale
        p = jax.nn.softmax(s, axis=-1)
        d = p[:, :, 0] - lam * p[:, :, 1]
        return jnp.einsum('bhqk,bkhv->bqhv', d.astype(vb.dtype), vb)

    nb = S // A_QBLOCK
    qblocks = jnp.moveaxis(q.reshape((B_, nb, A_QBLOCK) + q.shape[2:]), 1, 0)
    o = lax.map(lambda qb: attend(qb, k_all, v_all), qblocks)
    o = jnp.moveaxis(o, 0, 1).reshape(B_, S, A_HEADS, A_V)
    out = (rms_norm(o, g_sub) * (1.0 - lam_init)).reshape(B_, S, A_WIDTH)
    out_c = None
    if need_ctx:
        oc = attend(qc, kc, vc)
        out_c = (rms_norm(oc, g_sub) * (1.0 - lam_init)).reshape(B_, L, A_WIDTH)
    return out, out_c


def gla_scan(q, k, v, log_a, s0):
    B_, H, T, dk = q.shape
    n = T // B_CHUNK

    def chunks(t):
        return jnp.moveaxis(t.reshape(B_, H, n, B_CHUNK, t.shape[-1]), 2, 0)

    causal = jnp.tril(jnp.ones((B_CHUNK, B_CHUNK), dtype=bool))

    def step(s, inp):
        qc, kc, vc, ac = inp
        b = jnp.cumsum(ac, axis=2)
        rel = jnp.where(causal[:, :, None], b[:, :, :, None, :] - b[:, :, None, :, :], -jnp.inf)
        a_intra = jnp.einsum('bhtsd,bhsd->bhts', qc[:, :, :, None, :] * jnp.exp(rel), kc)
        o = (jnp.einsum('bhts,bhsv->bhtv', a_intra, vc)
             + jnp.einsum('bhtd,bhdv->bhtv', qc * jnp.exp(b), s))
        b_end = b[:, :, -1, :]
        s = (jnp.exp(b_end)[..., None] * s
             + jnp.einsum('bhsd,bhsv->bhdv', kc * jnp.exp(b_end[:, :, None, :] - b), vc))
        return s, o

    s_final, o = lax.scan(step, s0, (chunks(q), chunks(k), chunks(v), chunks(log_a)))
    o = jnp.moveaxis(o, 0, 2).reshape(B_, H, T, v.shape[-1])
    return o, s_final


def gla_mixer(q, k, v, r, glow, qc, kc, vc, rc, glowc, w_dec, b_dec, g_out, need_ctx):
    B_ = q.shape[0]

    def heads(t, d):
        return jnp.transpose(t.reshape(t.shape[0], t.shape[1], -1, d), (0, 2, 1, 3)).astype(F32)

    def decay(gl, direction):
        z = gl[..., direction * B_GATE_RANK:(direction + 1) * B_GATE_RANK] @ w_dec[direction] + b_dec[direction]
        return heads(jax.nn.log_sigmoid(z.astype(F32)) / B_GATE_TAU, B_DK)

    def flip(t):
        return jnp.flip(t, axis=2)

    scale = B_DK ** -0.5
    ql, kl, vl = heads(q, B_DK) * scale, heads(k, B_DK), heads(v, B_DV)
    qx, kx, vx = heads(qc, B_DK) * scale, heads(kc, B_DK), heads(vc, B_DV)
    s0 = jnp.zeros((B_, B_HEADS, B_DK, B_DV), F32)
    ox_f, sx_f = gla_scan(qx, kx, vx, decay(glowc, 0), s0)
    ol_f, _ = gla_scan(ql, kl, vl, decay(glow, 0), sx_f)
    ox_b, sx_b = gla_scan(flip(qx), flip(kx), flip(vx), flip(decay(glowc, 1)), s0)
    ol_b, _ = gla_scan(flip(ql), flip(kl), flip(vl), flip(decay(glow, 1)), sx_b)

    def readout(o, gate):
        o = jnp.transpose(rms_norm(o, g_out), (0, 2, 1, 3)).reshape(gate.shape[0], gate.shape[1], B_WIDTH)
        return (o * jax.nn.silu(gate.astype(F32))).astype(gate.dtype)

    out = readout(ol_f + flip(ol_b), r)
    out_c = readout(ox_f + flip(ox_b), rc) if need_ctx else None
    return out, out_c


def neighborhood_attention(q, k, v, qc, kc, vc, rpb, need_ctx):
    B_, S, H, dh = q.shape
    L = qc.shape[1]
    rows = S // GRID_W
    wr = min(NA_ROWS, rows)
    scale = dh ** -0.5

    def grid(t):
        return jnp.transpose(t.reshape(B_, rows, GRID_W, H, dh), (0, 3, 1, 2, 4))

    qg, kg, vg = grid(q), grid(k), grid(v)
    r = jnp.arange(rows)
    row_idx = jnp.clip(r - wr // 2, 0, rows - wr)[:, None] + jnp.arange(wr)
    cq = jnp.arange(GRID_W)
    col_start = jnp.clip(cq - NA_COLS // 2, 0, GRID_W - NA_COLS)
    col_mask = (cq[None, :] >= col_start[:, None]) & (cq[None, :] < col_start[:, None] + NA_COLS)
    k_rows = kg[:, :, row_idx]
    v_rows = vg[:, :, row_idx]
    s_nb = jnp.einsum('bhrqd,bhrwkd->bhrqwk', qg, k_rows).astype(F32) * scale
    dr = row_idx - r[:, None] + (NA_ROWS - 1)
    dc = jnp.clip(cq[None, :] - cq[:, None], -(NA_COLS - 1), NA_COLS - 1) + (NA_COLS - 1)
    bias = rpb[:, dr[:, None, :, None], dc[None, :, None, :]].astype(F32)
    s_nb = jnp.where(col_mask[:, None, :], s_nb + bias, -jnp.inf)
    s_c = jnp.einsum('bhrqd,bchd->bhrqc', qg, kc).astype(F32) * scale
    n_nb = wr * GRID_W
    p = jax.nn.softmax(jnp.concatenate([s_nb.reshape(B_, H, rows, GRID_W, n_nb), s_c], axis=-1), axis=-1)
    p_nb = p[..., :n_nb].reshape(s_nb.shape).astype(v.dtype)
    p_c = p[..., n_nb:].astype(v.dtype)
    o = (jnp.einsum('bhrqwk,bhrwkd->bhrqd', p_nb, v_rows)
         + jnp.einsum('bhrqc,bchd->bhrqd', p_c, vc))
    out = jnp.transpose(o, (0, 2, 3, 1, 4)).reshape(B_, S, H * dh)
    out_c = None
    if need_ctx:
        sc = jnp.einsum('bqhd,bkhd->bhqk', qc, kc).astype(F32) * scale
        out_c = jnp.einsum('bhqk,bkhd->bqhd', jax.nn.softmax(sc, axis=-1).astype(vc.dtype), vc).reshape(B_, L, H * dh)
    return out, out_c


def hier_moe(h, w_rg, b_rg, w_re, b_re, w_up, w_down):
    n_tok, D = h.shape
    n_assign = n_tok * TOP_K
    n_blocks = -(-(n_assign + N_EXPERTS * (MOE_BLOCK - 1)) // MOE_BLOCK)
    logit_g = (h @ w_rg + b_rg).astype(F32)
    grp = jnp.argmax(logit_g, axis=-1)
    p_grp = jnp.take_along_axis(jax.nn.softmax(logit_g, axis=-1), grp[:, None], axis=1)
    logit_e = (h @ w_re + b_re).astype(F32).reshape(n_tok, N_GROUPS, EXPERTS_PER_GROUP)
    logit_e = jnp.take_along_axis(logit_e, grp[:, None, None], axis=1)[:, 0]
    top_v, top_i = lax.top_k(logit_e, TOP_K)
    gate = jax.nn.softmax(top_v, axis=-1) * p_grp
    expert = (grp[:, None] * EXPERTS_PER_GROUP + top_i).reshape(-1)
    order = jnp.argsort(expert)
    e_sorted = expert[order]
    tok_sorted = order // TOP_K
    counts = jnp.bincount(expert, length=N_EXPERTS)
    padded = (counts + MOE_BLOCK - 1) // MOE_BLOCK * MOE_BLOCK
    start = jnp.cumsum(counts) - counts
    pad_end = jnp.cumsum(padded)
    pad_start = pad_end - padded
    dest = pad_start[e_sorted] + jnp.arange(n_assign) - start[e_sorted]
    buf = jnp.zeros((n_blocks * MOE_BLOCK, D), h.dtype).at[dest].set(h[tok_sorted])
    blk_expert = jnp.minimum(jnp.searchsorted(pad_end, jnp.arange(n_blocks) * MOE_BLOCK, side='right'), N_EXPERTS - 1)

    def expert_block(args):
        xb, e = args
        g, u = jnp.split(xb @ w_up[e], 2, axis=-1)
        return (jax.nn.silu(g) * u) @ w_down[e]

    y = lax.map(expert_block, (buf.reshape(n_blocks, MOE_BLOCK, D), blk_expert)).reshape(-1, D)
    y = y[dest] * gate.reshape(-1)[order][:, None].astype(h.dtype)
    return jax.ops.segment_sum(y, tok_sorted, num_segments=n_tok)


def hybrid_layer(x, xc, c_act, cc_act, rope, layer_idx, need_ctx,
                 w_mod, b_mod, g1, g2, w_in, w_out, lam, g_sub,
                 w_dec, b_dec, g_gla, rpb, w_rg, b_rg, w_re, b_re, w_up, w_down):
    B_, S, D = x.shape
    L = xc.shape[1]
    mod = (c_act @ w_mod + b_mod).reshape(B_, 6, 1, D)
    modc = (cc_act @ w_mod + b_mod).reshape(6, D)
    h = rms_norm(x, g1) * (1 + mod[:, 1]) + mod[:, 0]
    hc = rms_norm(xc, g1) * (1 + modc[1]) + modc[0]
    qa, ka, va, qb, kb, vb, rb, gb, qn, kn, vn = split_in(h @ w_in)
    qa_c, ka_c, va_c, qb_c, kb_c, vb_c, rb_c, gb_c, qn_c, kn_c, vn_c = split_in(hc @ w_in)

    lam_init = 0.8 - 0.6 * math.exp(-0.3 * layer_idx)
    lam_f = lam.astype(F32)
    lam_val = jnp.exp(jnp.sum(lam_f[0] * lam_f[1])) - jnp.exp(jnp.sum(lam_f[2] * lam_f[3])) + lam_init

    def a_qk(t):
        return t.reshape(t.shape[0], t.shape[1], A_HEADS, 2, A_QK)

    ya, ya_c = diff_attention(apply_axial_rope(a_qk(qa), rope), apply_axial_rope(a_qk(ka), rope),
                              va.reshape(B_, S, A_HEADS, A_V), a_qk(qa_c), a_qk(ka_c),
                              va_c.reshape(B_, L, A_HEADS, A_V), lam_val, lam_init, g_sub, need_ctx)
    yb, yb_c = gla_mixer(qb, kb, vb, rb, gb, qb_c, kb_c, vb_c, rb_c, gb_c, w_dec, b_dec, g_gla, need_ctx)

    def c_heads(t):
        return t.reshape(t.shape[0], t.shape[1], C_HEADS, C_DH)

    yn, yn_c = neighborhood_attention(c_heads(qn), c_heads(kn), c_heads(vn),
                                      c_heads(qn_c), c_heads(kn_c), c_heads(vn_c), rpb, need_ctx)
    x = x + mod[:, 2] * (jnp.concatenate([ya, yb, yn], axis=-1) @ w_out)
    h2 = rms_norm(x, g2) * (1 + mod[:, 4]) + mod[:, 3]
    if need_ctx:
        xc = xc + modc[2] * (jnp.concatenate([ya_c, yb_c, yn_c], axis=-1) @ w_out)
        h2c = rms_norm(xc, g2) * (1 + modc[4]) + modc[3]
        f = hier_moe(jnp.concatenate([h2.reshape(-1, D), h2c.reshape(-1, D)], axis=0),
                     w_rg, b_rg, w_re, b_re, w_up, w_down)
        x = x + mod[:, 5] * f[:B_ * S].reshape(B_, S, D)
        xc = xc + modc[5] * f[B_ * S:].reshape(B_, L, D)
    else:
        f = hier_moe(h2.reshape(-1, D), w_rg, b_rg, w_re, b_re, w_up, w_down)
        x = x + mod[:, 5] * f.reshape(B_, S, D)
    return x, xc


def setup_inputs(seed: int = 0) -> dict:
    key = jax.random.key(seed)
    ks = jax.random.split(key, 23)
    D = D_MODEL

    def nrm(k, shape, s):
        return jax.random.normal(k, shape, F32) * s

    return {
        'x': nrm(ks[0], (BATCH, SEQ, D), 1.0),
        'c': nrm(ks[1], (BATCH, D), 1.0),
        'ctx': nrm(ks[2], (BATCH, CTX_LEN, D), 1.0),
        'c_ctx': nrm(ks[3], (D,), 1.0),
        'w_mod': nrm(ks[4], (DEPTH, D, 6 * D), 0.5 * D ** -0.5),
        'b_mod': nrm(ks[5], (DEPTH, 6 * D), 0.02),
        'norm1_g': 1.0 + nrm(ks[6], (DEPTH, D), 0.02),
        'norm2_g': 1.0 + nrm(ks[7], (DEPTH, D), 0.02),
        'w_in': nrm(ks[8], (DEPTH, D, IN_WIDTH), D ** -0.5),
        'w_out': nrm(ks[9], (DEPTH, MIX_WIDTH, D), MIX_WIDTH ** -0.5),
        'diff_lambda': nrm(ks[10], (DEPTH, 4, A_QK), 0.1),
        'diff_sub_g': 1.0 + nrm(ks[11], (DEPTH, A_V), 0.02),
        'gla_w_decay': nrm(ks[12], (DEPTH, 2, B_GATE_RANK, B_HEADS * B_DK), B_GATE_RANK ** -0.5),
        'gla_b_decay': nrm(ks[13], (DEPTH, 2, B_HEADS * B_DK), 0.1),
        'gla_norm_g': 1.0 + nrm(ks[14], (DEPTH, B_DV), 0.02),
        'na_rel_bias': nrm(ks[15], (DEPTH, C_HEADS, 2 * NA_ROWS - 1, 2 * NA_COLS - 1), 0.02),
        'w_router_group': nrm(ks[16], (DEPTH, D, N_GROUPS), D ** -0.5),
        'b_router_group': nrm(ks[17], (DEPTH, N_GROUPS), 0.01),
        'w_router_expert': nrm(ks[18], (DEPTH, D, N_EXPERTS), D ** -0.5),
        'b_router_expert': nrm(ks[19], (DEPTH, N_EXPERTS), 0.01),
        'w_expert_up': nrm(ks[20], (DEPTH, N_EXPERTS, D, 2 * EXPERT_HIDDEN), D ** -0.5),
        'w_expert_down': nrm(ks[21], (DEPTH, N_EXPERTS, EXPERT_HIDDEN, D), EXPERT_HIDDEN ** -0.5),
        'final_g': 1.0 + nrm(ks[22], (D,), 0.02),
    }


def reference(x, c, ctx, c_ctx, w_mod, b_mod, norm1_g, norm2_g, w_in, w_out,
              diff_lambda, diff_sub_g, gla_w_decay, gla_b_decay, gla_norm_g, na_rel_bias,
              w_router_group, b_router_group, w_router_expert, b_router_expert,
              w_expert_up, w_expert_down, final_g):
    rope = axial_rope_tables(x.shape[1], x.dtype)
    c_act = jax.nn.silu(c)
    cc_act = jax.nn.silu(c_ctx)
    xc = ctx
    for l in range(DEPTH):
        x, xc = hybrid_layer(x, xc, c_act, cc_act, rope, l, l < DEPTH - 1,
                             w_mod[l], b_mod[l], norm1_g[l], norm2_g[l], w_in[l], w_out[l],
                             diff_lambda[l], diff_sub_g[l], gla_w_decay[l], gla_b_decay[l],
                             gla_norm_g[l], na_rel_bias[l], w_router_group[l], b_router_group[l],
                             w_router_expert[l], b_router_expert[l], w_expert_up[l], w_expert_down[l])
    return rms_norm(x, final_g)
```

```cpp
#ifndef EMU
#include <hip/hip_runtime.h>
#endif
#include <stdint.h>
#include <stddef.h>
#include <math.h>

#ifdef EMU
#include <chrono>
#ifndef E_D
#define E_D 256
#define E_B 2
#define E_S 1024
#define E_DEPTH 2
#define E_L 128
#define E_EH 128
#endif
constexpr int D = E_D, NB = E_B, S = E_S, DEPTH = E_DEPTH, L = E_L, EH = E_EH;
#else
constexpr int D = 1024, NB = 8, S = 4096, DEPTH = 4, L = 256, EH = 512;
#endif
constexpr int NL = NB * S, NC = NB * L, NT = NL + NC;
constexpr int IMG_ROWS = S / 64;
constexpr int PW = 3104;
constexpr int C_QA = 0, C_KA = 512, C_VA = 1024, C_QB = 1536, C_KB = 1664, C_VB = 1792, C_RB = 2048, C_GB = 2304, C_QN = 2336, C_KN = 2592, C_VN = 2848;
constexpr int MIXW = 1024;
constexpr int NEXP = 32;
constexpr int LC = L / 64, SC = S / 64, NCH = LC + SC;
constexpr int NTHREADS = 512;
constexpr float LOG2E = 1.4426950408889634f;
constexpr float NORM_EPS = 1e-6f;
constexpr int YROWS = 2 * NT + NEXP * 128;

typedef unsigned short bf16_t;
typedef short bf16x8 __attribute__((ext_vector_type(8)));
typedef short bf16x4 __attribute__((ext_vector_type(4)));
typedef float f32x4 __attribute__((ext_vector_type(4)));
typedef float f32x16 __attribute__((ext_vector_type(16)));
typedef unsigned u32x4 __attribute__((ext_vector_type(4)));
typedef unsigned u32x2 __attribute__((ext_vector_type(2)));

#ifdef EMU
#define MFMA32(a, b, c) emu_mfma32(a, b, c)
#define MFMA16(a, b, c) emu_mfma16(a, b, c)
#define DYN_LDS(name) char* name = emu::dyn_lds()
#define EXP2F(x) exp2f(x)
#else
#define MFMA32(a, b, c) __builtin_amdgcn_mfma_f32_32x32x16_bf16(a, b, c, 0, 0, 0)
#define MFMA16(a, b, c) __builtin_amdgcn_mfma_f32_16x16x32_bf16(a, b, c, 0, 0, 0)
#define DYN_LDS(name) extern __shared__ __attribute__((aligned(16))) char name[]
#define EXP2F(x) __builtin_amdgcn_exp2f(x)
#endif

__device__ __forceinline__ unsigned f2u(float f) { return __builtin_bit_cast(unsigned, f); }
__device__ __forceinline__ float u2f(unsigned u) { return __builtin_bit_cast(float, u); }
__device__ __forceinline__ bf16_t f2bf(float f) { unsigned u = f2u(f); u += 0x7fffu + ((u >> 16) & 1u); return (bf16_t)(u >> 16); }
__device__ __forceinline__ float bf2f(bf16_t h) { return u2f((unsigned)h << 16); }
__device__ __forceinline__ unsigned pack2(float lo, float hi) { return (unsigned)f2bf(lo) | ((unsigned)f2bf(hi) << 16); }
__device__ __forceinline__ float siluf(float x) { return x / (1.0f + expf(-x)); }
__device__ __forceinline__ float log_sigmoidf(float x) { return fminf(x, 0.f) - log1pf(expf(-fabsf(x))); }
__device__ __forceinline__ float wave_sum(float v) {
#pragma unroll
    for (int m = 32; m >= 1; m >>= 1) v += __shfl_xor(v, m);
    return v;
}

constexpr size_t al256(size_t x) { return (x + 255) & ~(size_t)255; }
constexpr size_t BAR_BYTES = 16384;
constexpr size_t OFF_BAR = 0;
constexpr size_t OFF_CNT = OFF_BAR + BAR_BYTES;
constexpr size_t ZERO_BYTES = OFF_CNT + 4096;
constexpr size_t OFF_ROPE = ZERO_BYTES;
constexpr size_t OFF_MOD = OFF_ROPE + 8192;
constexpr size_t OFF_WIN = al256(OFF_MOD + (size_t)DEPTH * 9 * 6 * D * 4);
constexpr size_t OFF_WOUT = al256(OFF_WIN + (size_t)DEPTH * PW * D * 2);
constexpr size_t OFF_WUP = al256(OFF_WOUT + (size_t)DEPTH * D * MIXW * 2);
constexpr size_t OFF_WDN = al256(OFF_WUP + (size_t)DEPTH * NEXP * 2 * EH * D * 2);
constexpr size_t OFF_X = al256(OFF_WDN + (size_t)DEPTH * NEXP * D * EH * 2);
constexpr size_t OFF_H = al256(OFF_X + (size_t)NT * D * 4);
constexpr size_t OFF_P = al256(OFF_H + (size_t)NT * D * 2);
constexpr size_t OFF_MIX = al256(OFF_P + (size_t)NT * PW * 2);
constexpr size_t OFF_GKV = al256(OFF_MIX + (size_t)NT * MIXW * 2);
constexpr size_t OFF_GDEC = al256(OFF_GKV + (size_t)NB * 4 * 2 * NCH * 2048 * 4);
constexpr size_t OFF_ROUTE = al256(OFF_GDEC + (size_t)NB * 4 * 2 * NCH * 32 * 4);
constexpr size_t OFF_LIST = al256(OFF_ROUTE + (size_t)NT * 32);
constexpr size_t OFF_ACT = al256(OFF_LIST + (size_t)NEXP * NT * 4);
constexpr size_t OFF_Y = al256(OFF_ACT + (size_t)YROWS * EH * 2);
constexpr size_t WS_TOTAL = al256(OFF_Y + (size_t)YROWS * D * 2);

struct Params {
    const float* x; const float* c; const float* ctx; const float* c_ctx; const float* w_mod; const float* b_mod;
    const float* g1; const float* g2; const float* w_in; const float* w_out; const float* lam; const float* g_sub;
    const float* w_dec; const float* b_dec; const float* g_gla; const float* rpb; const float* w_rg; const float* b_rg;
    const float* w_re; const float* b_re; const float* w_up; const float* w_dn; const float* g_fin;
    float* out; char* ws;
};

#ifdef EMU
struct GridBar { unsigned* ctr; };
__device__ __forceinline__ void grid_barrier(GridBar& gb) { __shared__ unsigned gen; emu_grid_barrier(gb.ctr, gen); }
#else
#define XB_TMO      128
#define XB_XCNT(j)  (256  + 64 * (j))
#define XB_XSUB(j)  (1280 + 64 * (j))
#define XB_XGEN(j)  (2304 + 64 * (j))
#define XB_TOP      3328
#define XB_TOPGEN   3392
#define XCD_BAR_WORDS 3456
#define XB_SPIN_CAP (1u << 22)
#define LAS __attribute__((address_space(3)))
__device__ __forceinline__ unsigned xb_ld(unsigned* p)              { return __hip_atomic_load(p, __ATOMIC_RELAXED, __HIP_MEMORY_SCOPE_AGENT); }
__device__ __forceinline__ unsigned xb_add(unsigned* p, unsigned v) { return __hip_atomic_fetch_add(p, v, __ATOMIC_RELAXED, __HIP_MEMORY_SCOPE_AGENT); }
__device__ __forceinline__ unsigned xb_xcc_id() { return (unsigned)__builtin_amdgcn_s_getreg((3 << 11) | 20) & 0xFu; }
#define XB_SPIN(cond, bar) do { unsigned _sp = 0; while (cond) { __builtin_amdgcn_s_sleep(1); \
    if ((++_sp & 255u) == 0u) { if (xb_ld(&(bar)[XB_TMO])) break; if (_sp > XB_SPIN_CAP) { atomicAdd(&(bar)[XB_TMO], 1u); break; } } } } while (0)
struct XcdBarrier { unsigned* bar; unsigned x; volatile LAS unsigned* st; };
__device__ __forceinline__ XcdBarrier xcd_barrier_post(unsigned* bar, volatile LAS unsigned* st) {
    XcdBarrier b; b.bar = bar; b.x = xb_xcc_id(); b.st = st;
    if (threadIdx.x == 0) (void)xb_add(&bar[XB_XCNT(b.x)], 1u);
    return b;
}
__device__ __forceinline__ void xcd_barrier_complete(unsigned* bar, unsigned x, unsigned& nloc, unsigned& nx) {
    const unsigned G = gridDim.x * gridDim.y * gridDim.z;
    unsigned sum, cnt, mine, sp = 0u;
    for (;;) {
        sum = 0u; cnt = 0u; mine = 0u;
#pragma unroll
        for (unsigned j = 0; j < 16; ++j) { const unsigned c = xb_ld(&bar[XB_XCNT(j)]); sum += c; cnt += (c > 0u) ? 1u : 0u; mine = (j == x) ? c : mine; }
        if (sum == G) break;
        __builtin_amdgcn_s_sleep(1);
        if ((++sp & 255u) == 0u) { if (xb_ld(&bar[XB_TMO])) break; if (sp > XB_SPIN_CAP) { atomicAdd(&bar[XB_TMO], 1u); break; } }
    }
    nloc = mine > 0u ? mine : 1u; nx = cnt > 0u ? cnt : 1u;
}
__device__ __forceinline__ void xcd_barrier(const XcdBarrier& b) {
    asm volatile("s_waitcnt vmcnt(0)" ::: "memory");
    __syncthreads();
    if (threadIdx.x == 0) {
        unsigned* bar = b.bar;
        __builtin_amdgcn_s_waitcnt(0);
        unsigned nloc = b.st[0], nx = b.st[1];
        if (nloc == 0u) { xcd_barrier_complete(bar, b.x, nloc, nx); b.st[0] = nloc; b.st[1] = nx; }
        const unsigned old = xb_add(&bar[XB_XSUB(b.x)], 1u);
        const unsigned gen = old / nloc;
        if (old + 1u == (gen + 1u) * nloc) {
            __builtin_amdgcn_fence(__ATOMIC_RELEASE, "agent");
            asm volatile("s_waitcnt vmcnt(0)" ::: "memory");
            const unsigned og = xb_add(&bar[XB_TOP], 1u);
            const unsigned tg = og / nx;
            if (og + 1u == (tg + 1u) * nx) xb_add(&bar[XB_TOPGEN], 1u);
            else XB_SPIN(xb_ld(&bar[XB_TOPGEN]) == tg, bar);
            __builtin_amdgcn_fence(__ATOMIC_ACQUIRE, "agent");
            xb_add(&bar[XB_XGEN(b.x)], 1u);
            asm volatile("s_waitcnt vmcnt(0)" ::: "memory");
        } else {
            XB_SPIN(xb_ld(&bar[XB_XGEN(b.x)]) == gen, bar);
            __builtin_amdgcn_fence(__ATOMIC_ACQUIRE, "agent");
            asm volatile("s_waitcnt vmcnt(0)" ::: "memory");
        }
    }
    __syncthreads();
}
typedef XcdBarrier GridBar;
__device__ __forceinline__ void grid_barrier(GridBar& gb) { xcd_barrier(gb); }
#endif

struct CvtDesc { const float* src; bf16_t* dst; int K, N, perm; };
__device__ __forceinline__ int up_perm(int n) { const int j = n < EH ? n : n - EH; return (j >> 4) * 32 + (n < EH ? 0 : 16) + (j & 15); }

__device__ void cvt_tile(const CvtDesc& d, int tk, int tn, char* lds) {
    float* t = (float*)lds;
    const int tid = threadIdx.x;
    __syncthreads();
#pragma unroll
    for (int i = 0; i < 8; ++i) {
        const int e = tid + i * NTHREADS, kk = e >> 6, nn = e & 63;
        const int k = tk * 64 + kk, n = tn * 64 + nn;
        t[kk * 65 + nn] = (n < d.N) ? d.src[(size_t)k * d.N + n] : 0.f;
    }
    __syncthreads();
    const int nn = tid >> 3, kc = tid & 7, n = tn * 64 + nn;
    if (n < d.N) {
        const int nd = d.perm ? up_perm(n) : n;
        u32x4 v;
        v[0] = pack2(t[(kc * 8 + 0) * 65 + nn], t[(kc * 8 + 1) * 65 + nn]);
        v[1] = pack2(t[(kc * 8 + 2) * 65 + nn], t[(kc * 8 + 3) * 65 + nn]);
        v[2] = pack2(t[(kc * 8 + 4) * 65 + nn], t[(kc * 8 + 5) * 65 + nn]);
        v[3] = pack2(t[(kc * 8 + 6) * 65 + nn], t[(kc * 8 + 7) * 65 + nn]);
        *(u32x4*)(d.dst + (size_t)nd * d.K + tk * 64 + kc * 8) = v;
    }
}

__device__ void phase_prologue(const Params& p, char* lds) {
    const int tid = threadIdx.x, bid = blockIdx.x, G = gridDim.x;
    if (bid == 0) {
        float* rope = (float*)(p.ws + OFF_ROPE);
        for (int e = tid; e < 64 * 16; e += NTHREADS) {
            const int pos = e >> 4, i = e & 15;
            const float inv = powf(10000.0f, -(float)i / 16.0f);
            const float ang = (float)pos * inv;
            rope[e * 2] = cosf(ang); rope[e * 2 + 1] = sinf(ang);
        }
    }
    {
        constexpr int T_IN = (D / 64) * ((PW + 63) / 64), T_OUT = (MIXW / 64) * (D / 64), T_UP = (D / 64) * (2 * EH / 64), T_DN = (EH / 64) * (D / 64);
        constexpr int PER_LAYER = T_IN + T_OUT + NEXP * (T_UP + T_DN);
        for (int it = bid; it < DEPTH * PER_LAYER; it += G) {
            const int l = it / PER_LAYER; int r = it % PER_LAYER;
            CvtDesc d;
            if (r < T_IN) { d.src = p.w_in + (size_t)l * D * PW; d.dst = (bf16_t*)(p.ws + OFF_WIN) + (size_t)l * PW * D; d.K = D; d.N = PW; d.perm = 0; }
            else if ((r -= T_IN) < T_OUT) { d.src = p.w_out + (size_t)l * MIXW * D; d.dst = (bf16_t*)(p.ws + OFF_WOUT) + (size_t)l * D * MIXW; d.K = MIXW; d.N = D; d.perm = 0; }
            else if ((r -= T_OUT) < NEXP * T_UP) { const int e = r / T_UP; r %= T_UP; d.src = p.w_up + ((size_t)l * NEXP + e) * D * 2 * EH; d.dst = (bf16_t*)(p.ws + OFF_WUP) + ((size_t)l * NEXP + e) * 2 * EH * D; d.K = D; d.N = 2 * EH; d.perm = 1; }
            else { r -= NEXP * T_UP; const int e = r / T_DN; r %= T_DN; d.src = p.w_dn + ((size_t)l * NEXP + e) * EH * D; d.dst = (bf16_t*)(p.ws + OFF_WDN) + ((size_t)l * NEXP + e) * D * EH; d.K = EH; d.N = D; d.perm = 0; }
            const int nkt = d.K / 64;
            cvt_tile(d, r % nkt, r / nkt, lds);
        }
    }
    {
        float* cact = (float*)lds;
        float* red = cact + (NB + 1) * D;
        __syncthreads();
        for (int e = tid; e < (NB + 1) * D; e += NTHREADS) { const int r = e / D, k = e % D; const float v = r < NB ? p.c[r * D + k] : p.c_ctx[k]; cact[e] = siluf(v); }
        __syncthreads();
        constexpr int NBLK = 6 * D / 64;
        float* mod = (float*)(p.ws + OFF_MOD);
        for (int it = bid; it < DEPTH * NBLK; it += G) {
            const int l = it / NBLK, n0 = (it % NBLK) * 64, ks = tid >> 6, nn = tid & 63;
            float acc[NB + 1];
#pragma unroll
            for (int r = 0; r <= NB; ++r) acc[r] = 0.f;
            const float* w = p.w_mod + (size_t)l * D * 6 * D + n0 + nn;
            for (int k = ks * (D / 8); k < (ks + 1) * (D / 8); ++k) {
                const float wv = w[(size_t)k * 6 * D];
#pragma unroll
                for (int r = 0; r <= NB; ++r) acc[r] += cact[r * D + k] * wv;
            }
#pragma unroll
            for (int r = 0; r <= NB; ++r) red[(ks * 64 + nn) * (NB + 1) + r] = acc[r];
            __syncthreads();
            for (int e = tid; e < 64 * (NB + 1); e += NTHREADS) {
                const int r = e / 64, n2 = e % 64; float s = 0.f;
#pragma unroll
                for (int q = 0; q < 8; ++q) s += red[(q * 64 + n2) * (NB + 1) + r];
                mod[((size_t)l * (NB + 1) + r) * 6 * D + n0 + n2] = s + p.b_mod[(size_t)l * 6 * D + n0 + n2];
            }
            __syncthreads();
        }
    }
}

__device__ __forceinline__ void load_pad_start(const Params& p, int layer, int* ps) {
    if (threadIdx.x == 0) {
        const int* cnt = (const int*)(p.ws + OFF_CNT) + layer * NEXP; int a = 0;
        for (int e = 0; e < NEXP; ++e) { ps[e] = a; a += (cnt[e] + 127) / 128 * 128; }
        ps[NEXP] = a;
    }
}
__device__ __forceinline__ int tok_batch(int t) { return t < NL ? t / S : NB; }

template <int MODE>
__device__ void phase_norm(const Params& p, int l, char* lds) {
    const int tid = threadIdx.x, lane = tid & 63, wave = tid >> 6, G = gridDim.x;
    int* ps = (int*)lds;
    float* wr = (float*)(lds + 256);
    float* X = (float*)(p.ws + OFF_X);
    bf16_t* H = (bf16_t*)(p.ws + OFF_H);
    const bf16_t* Y = (const bf16_t*)(p.ws + OFF_Y);
    const int* route = (const int*)(p.ws + OFF_ROUTE);
    const float* mod = (const float*)(p.ws + OFF_MOD);
    __syncthreads();
    const bool combine = (MODE == 0 && l > 0) || MODE == 2;
    const int lprev = MODE == 2 ? DEPTH - 1 : l - 1;
    if (combine) load_pad_start(p, lprev, ps);
    if (MODE == 1) {
        for (int e = tid; e < 36 * D; e += NTHREADS) { const int o = e / D, k = e % D;
            wr[e] = o < 4 ? p.w_rg[((size_t)l * D + k) * 4 + o] : p.w_re[((size_t)l * D + k) * 32 + (o - 4)]; }
    }
    __syncthreads();
    const int ntok = (MODE == 2) ? NL : ((MODE == 1 && l == DEPTH - 1) ? NL : NT);
    for (int t = blockIdx.x * 8 + wave; t < ntok; t += G * 8) {
        const int mr = tok_batch(t);
        float xv[D / 64];
        if (MODE == 0 && l == 0) {
            const float* src = t < NL ? p.x + (size_t)t * D : p.ctx + (size_t)(t - NL) * D;
#pragma unroll
            for (int i = 0; i < D / 256; ++i) { const f32x4 v = *(const f32x4*)(src + i * 256 + lane * 4); xv[4 * i] = v[0]; xv[4 * i + 1] = v[1]; xv[4 * i + 2] = v[2]; xv[4 * i + 3] = v[3]; }
        } else {
            const float* src = X + (size_t)t * D;
#pragma unroll
            for (int i = 0; i < D / 256; ++i) { const f32x4 v = *(const f32x4*)(src + i * 256 + lane * 4); xv[4 * i] = v[0]; xv[4 * i + 1] = v[1]; xv[4 * i + 2] = v[2]; xv[4 * i + 3] = v[3]; }
        }
        if (combine) {
            const int* rt = route + (size_t)t * 8;
            const int e0 = rt[0], e1 = rt[1], s0 = rt[2], s1 = rt[3];
            const float g0 = u2f((unsigned)rt[4]), g1 = u2f((unsigned)rt[5]);
            const bf16_t* y0 = Y + (size_t)(ps[e0] + s0) * D; const bf16_t* y1 = Y + (size_t)(ps[e1] + s1) * D;
            const float* m5 = mod + ((size_t)lprev * (NB + 1) + mr) * 6 * D + 5 * D;
#pragma unroll
            for (int i = 0; i < D / 256; ++i) {
                const u32x2 a = *(const u32x2*)(y0 + i * 256 + lane * 4), b = *(const u32x2*)(y1 + i * 256 + lane * 4);
                const f32x4 mv = *(const f32x4*)(m5 + i * 256 + lane * 4);
                xv[4 * i + 0] += mv[0] * (g0 * u2f(a[0] << 16) + g1 * u2f(b[0] << 16));
                xv[4 * i + 1] += mv[1] * (g0 * u2f(a[0] & 0xffff0000u) + g1 * u2f(b[0] & 0xffff0000u));
                xv[4 * i + 2] += mv[2] * (g0 * u2f(a[1] << 16) + g1 * u2f(b[1] << 16));
                xv[4 * i + 3] += mv[3] * (g0 * u2f(a[1] & 0xffff0000u) + g1 * u2f(b[1] & 0xffff0000u));
            }
        }
        if (MODE == 0) {
            float* dst = X + (size_t)t * D;
#pragma unroll
            for (int i = 0; i < D / 256; ++i) { f32x4 v = {xv[4 * i], xv[4 * i + 1], xv[4 * i + 2], xv[4 * i + 3]}; *(f32x4*)(dst + i * 256 + lane * 4) = v; }
        }
        float ss = 0.f;
#pragma unroll
        for (int i = 0; i < D / 64; ++i) ss += xv[i] * xv[i];
        ss = wave_sum(ss);
        const float rstd = 1.0f / sqrtf(ss / (float)D + NORM_EPS);
        if (MODE == 2) {
            float* dst = p.out + (size_t)t * D;
#pragma unroll
            for (int i = 0; i < D / 256; ++i) { const f32x4 g = *(const f32x4*)(p.g_fin + i * 256 + lane * 4);
                f32x4 v = {xv[4 * i] * rstd * g[0], xv[4 * i + 1] * rstd * g[1], xv[4 * i + 2] * rstd * g[2], xv[4 * i + 3] * rstd * g[3]}; *(f32x4*)(dst + i * 256 + lane * 4) = v; }
            continue;
        }
        const float* gg = (MODE == 0 ? p.g1 : p.g2) + (size_t)l * D;
        const float* mrow = mod + ((size_t)l * (NB + 1) + mr) * 6 * D;
        const float* shift = mrow + (MODE == 0 ? 0 : 3) * D; const float* scale = mrow + (MODE == 0 ? 1 : 4) * D;
        float hv[D / 64];
#pragma unroll
        for (int i = 0; i < D / 256; ++i) {
            const f32x4 g = *(const f32x4*)(gg + i * 256 + lane * 4), sh = *(const f32x4*)(shift + i * 256 + lane * 4), sc = *(const f32x4*)(scale + i * 256 + lane * 4);
#pragma unroll
            for (int j = 0; j < 4; ++j) hv[4 * i + j] = xv[4 * i + j] * rstd * g[j] * (1.0f + sc[j]) + sh[j];
            u32x2 o; o[0] = pack2(hv[4 * i], hv[4 * i + 1]); o[1] = pack2(hv[4 * i + 2], hv[4 * i + 3]);
            *(u32x2*)(H + (size_t)t * D + i * 256 + lane * 4) = o;
        }
        if (MODE == 1) {
            float* lgs = wr + 36 * D + wave * 64;
#pragma unroll 2
            for (int o = 0; o < 36; ++o) {
                float a = 0.f;
#pragma unroll
                for (int i = 0; i < D / 256; ++i) { const f32x4 w = *(const f32x4*)(wr + o * D + i * 256 + lane * 4);
                    a += hv[4 * i] * w[0] + hv[4 * i + 1] * w[1] + hv[4 * i + 2] * w[2] + hv[4 * i + 3] * w[3]; }
                a = wave_sum(a);
                if (lane == 0) lgs[o] = a;
            }
            if (lane == 0) {
                float lg[36];
#pragma unroll
                for (int o = 0; o < 36; ++o) lg[o] = lgs[o];
                int grp = 0; float gmax = -INFINITY;
#pragma unroll
                for (int o = 0; o < 4; ++o) { lg[o] += p.b_rg[l * 4 + o]; if (lg[o] > gmax) { gmax = lg[o]; grp = o; } }
                float gs = 0.f;
#pragma unroll
                for (int o = 0; o < 4; ++o) gs += expf(lg[o] - gmax);
                const float pg = 1.0f / gs;
                float v0 = -INFINITY, v1 = -INFINITY; int i0 = 0, i1 = 0;
#pragma unroll
                for (int g = 0; g < 4; ++g) {
                    if (g == grp) {
#pragma unroll
                        for (int o = 0; o < 8; ++o) { const float v = lg[4 + g * 8 + o] + p.b_re[l * 32 + g * 8 + o];
                            if (v > v0) { v1 = v0; i1 = i0; v0 = v; i0 = o; } else if (v > v1) { v1 = v; i1 = o; } }
                    }
                }
                const float e1v = expf(v1 - v0), den = 1.0f / (1.0f + e1v);
                const float g0 = den * pg, g1 = e1v * den * pg;
                const int e0 = grp * 8 + i0, e1 = grp * 8 + i1;
                int* cnt = (int*)(p.ws + OFF_CNT) + l * NEXP; int* list = (int*)(p.ws + OFF_LIST);
                const int s0 = atomicAdd(&cnt[e0], 1), s1 = atomicAdd(&cnt[e1], 1);
                list[(size_t)e0 * NT + s0] = t; list[(size_t)e1 * NT + s1] = t;
                int* rt = (int*)(p.ws + OFF_ROUTE) + (size_t)t * 8;
                rt[0] = e0; rt[1] = e1; rt[2] = s0; rt[3] = s1; rt[4] = (int)f2u(g0); rt[5] = (int)f2u(g1);
            }
        }
    }
}

constexpr int GBM = 128, GBN = 256, GBK = 64, GLD = 72;
constexpr int GEMM_LDS = (GBM + GBN) * GLD * 2;

template <class ARow, class Epi>
__device__ void gemm_tile(const bf16_t* A, int lda, ARow arow, const bf16_t* Bt, int ldb, int K, int m0, int n0, int Nvalid, Epi epi, char* lds) {
    bf16_t* As = (bf16_t*)lds; bf16_t* Bs = As + GBM * GLD;
    const int tid = threadIdx.x, lane = tid & 63, wave = tid >> 6, wm = wave >> 2, wn = wave & 3, fr = lane & 15, fq = lane >> 4;
    const bf16_t* ap[2]; const bf16_t* bp[4];
#pragma unroll
    for (int i = 0; i < 2; ++i) { const int c = tid + i * NTHREADS, r = c >> 3, ch = c & 7; ap[i] = A + (size_t)arow(m0 + r) * lda + ch * 8; }
#pragma unroll
    for (int i = 0; i < 4; ++i) { const int c = tid + i * NTHREADS, r = c >> 3, ch = c & 7; int n = n0 + r; n = n < Nvalid ? n : Nvalid - 1; bp[i] = Bt + (size_t)n * ldb + ch * 8; }
    f32x4 acc[4][4];
#pragma unroll
    for (int i = 0; i < 4; ++i)
#pragma unroll
        for (int j = 0; j < 4; ++j) acc[i][j] = (f32x4){0.f, 0.f, 0.f, 0.f};
    u32x4 ra[2], rb[4];
#pragma unroll
    for (int i = 0; i < 2; ++i) ra[i] = *(const u32x4*)(ap[i]);
#pragma unroll
    for (int i = 0; i < 4; ++i) rb[i] = *(const u32x4*)(bp[i]);
    for (int k0 = 0; k0 < K; k0 += GBK) {
        __syncthreads();
#pragma unroll
        for (int i = 0; i < 2; ++i) { const int c = tid + i * NTHREADS, r = c >> 3, ch = c & 7; *(u32x4*)(As + r * GLD + ch * 8) = ra[i]; }
#pragma unroll
        for (int i = 0; i < 4; ++i) { const int c = tid + i * NTHREADS, r = c >> 3, ch = c & 7; *(u32x4*)(Bs + r * GLD + ch * 8) = rb[i]; }
        __syncthreads();
        if (k0 + GBK < K) {
#pragma unroll
            for (int i = 0; i < 2; ++i) ra[i] = *(const u32x4*)(ap[i] + k0 + GBK);
#pragma unroll
            for (int i = 0; i < 4; ++i) rb[i] = *(const u32x4*)(bp[i] + k0 + GBK);
        }
#pragma unroll
        for (int ks = 0; ks < 2; ++ks) {
            bf16x8 af[4], bfr[4];
#pragma unroll
            for (int i = 0; i < 4; ++i) af[i] = *(const bf16x8*)(As + (wm * 64 + i * 16 + fr) * GLD + ks * 32 + fq * 8);
#pragma unroll
            for (int j = 0; j < 4; ++j) bfr[j] = *(const bf16x8*)(Bs + (wn * 64 + j * 16 + fr) * GLD + ks * 32 + fq * 8);
#pragma unroll
            for (int i = 0; i < 4; ++i)
#pragma unroll
                for (int j = 0; j < 4; ++j) acc[i][j] = MFMA16(bfr[j], af[i], acc[i][j]);
        }
    }
#pragma unroll
    for (int i = 0; i < 4; ++i) epi(m0 + wm * 64 + i * 16 + fr, n0 + wn * 64 + 4 * fq, acc[i]);
}

struct RowIdent { __device__ __forceinline__ int operator()(int m) const { return m; } };

struct EpiIn {
    bf16_t* P; const float* rope;
    __device__ __forceinline__ void operator()(int m, int nb, const f32x4 (&a)[4]) const {
        f32x4 v[4] = {a[0], a[1], a[2], a[3]};
        const int n64 = nb & ~63;
        if (n64 < C_VA) {
            if (m < NL) {
                const int s = m % S, prow = s >> 6, pcol = s & 63;
#pragma unroll
                for (int j = 0; j < 4; ++j) {
                    const int i = (nb & 15) + j;
                    const float cr = rope[(prow * 16 + i) * 2], sr = rope[(prow * 16 + i) * 2 + 1];
                    const float cc = rope[(pcol * 16 + i) * 2], sc = rope[(pcol * 16 + i) * 2 + 1];
                    const float x1 = v[0][j], x2 = v[1][j], x3 = v[2][j], x4 = v[3][j];
                    v[0][j] = x1 * cr - x2 * sr; v[1][j] = x2 * cr + x1 * sr; v[2][j] = x3 * cc - x4 * sc; v[3][j] = x4 * cc + x3 * sc;
                }
            }
        }
#pragma unroll
        for (int nf = 0; nf < 4; ++nf) {
            const int n = nb + 16 * nf;
            float sc = 1.0f;
            if (n < C_KA) sc = 0.125f * LOG2E;
            else if (n >= C_QB && n < C_KB) sc = 0.17677669529663687f;
            else if (n >= C_QN && n < C_KN) sc = 0.125f * LOG2E;
            if (n < PW) { u32x2 o; o[0] = pack2(v[nf][0] * sc, v[nf][1] * sc); o[1] = pack2(v[nf][2] * sc, v[nf][3] * sc); *(u32x2*)(P + (size_t)m * PW + n) = o; }
        }
    }
};
__device__ void phase_gemm_in(const Params& p, int l, char* lds) {
    constexpr int NMT = NT / GBM, NNT = (PW + GBN - 1) / GBN;
    EpiIn epi{(bf16_t*)(p.ws + OFF_P), (const float*)(p.ws + OFF_ROPE)};
    const bf16_t* A = (const bf16_t*)(p.ws + OFF_H); const bf16_t* Bt = (const bf16_t*)(p.ws + OFF_WIN) + (size_t)l * PW * D;
    for (int it = blockIdx.x; it < NMT * NNT; it += gridDim.x) {
        const int tm = it % NMT, tn = it / NMT;
        gemm_tile(A, D, RowIdent(), Bt, D, D, tm * GBM, tn * GBN, PW, epi, lds);
    }
}

struct EpiOut {
    float* X; const float* mod_l;
    __device__ __forceinline__ void operator()(int m, int nb, const f32x4 (&a)[4]) const {
        const float* g = mod_l + (size_t)tok_batch(m) * 6 * D + 2 * D;
#pragma unroll
        for (int nf = 0; nf < 4; ++nf) { const int n = nb + 16 * nf; float* xp = X + (size_t)m * D + n;
            const f32x4 gv = *(const f32x4*)(g + n); f32x4 xv = *(const f32x4*)xp;
            xv[0] += gv[0] * a[nf][0]; xv[1] += gv[1] * a[nf][1]; xv[2] += gv[2] * a[nf][2]; xv[3] += gv[3] * a[nf][3];
            *(f32x4*)xp = xv; }
    }
};
__device__ void phase_gemm_out(const Params& p, int l, char* lds) {
    const int M = (l == DEPTH - 1) ? NL : NT;
    const int NMT = M / GBM; constexpr int NNT = D / GBN;
    EpiOut epi{(float*)(p.ws + OFF_X), (const float*)(p.ws + OFF_MOD) + (size_t)l * (NB + 1) * 6 * D};
    const bf16_t* A = (const bf16_t*)(p.ws + OFF_MIX); const bf16_t* Bt = (const bf16_t*)(p.ws + OFF_WOUT) + (size_t)l * D * MIXW;
    for (int it = blockIdx.x; it < NMT * NNT; it += gridDim.x) {
        const int tm = it % NMT, tn = it / NMT;
        gemm_tile(A, MIXW, RowIdent(), Bt, MIXW, MIXW, tm * GBM, tn * GBN, D, epi, lds);
    }
}

struct RowList { const int* list; int cnt; int base; __device__ __forceinline__ int operator()(int m) const { const int s = m - base; return list[s < cnt ? s : cnt - 1]; } };
struct EpiUp {
    bf16_t* act; int row0; int cnt; int mbase;
    __device__ __forceinline__ void operator()(int m, int nb, const f32x4 (&a)[4]) const {
        const int s = m - mbase; if (s >= cnt) return;
        bf16_t* dst = act + (size_t)(row0 + s) * EH;
#pragma unroll
        for (int pr = 0; pr < 2; ++pr) {
            const int n = nb + 32 * pr;
            const int j = (n >> 5) * 16 + (n & 15);
            const f32x4 g = a[2 * pr], u = a[2 * pr + 1];
            u32x2 o; o[0] = pack2(siluf(g[0]) * u[0], siluf(g[1]) * u[1]); o[1] = pack2(siluf(g[2]) * u[2], siluf(g[3]) * u[3]);
            *(u32x2*)(dst + j) = o;
        }
    }
};
struct EpiDown {
    bf16_t* y; int row0; int cnt; int mbase;
    __device__ __forceinline__ void operator()(int m, int nb, const f32x4 (&a)[4]) const {
        const int s = m - mbase; if (s >= cnt) return;
        bf16_t* dst = y + (size_t)(row0 + s) * D;
#pragma unroll
        for (int nf = 0; nf < 4; ++nf) { u32x2 o; o[0] = pack2(a[nf][0], a[nf][1]); o[1] = pack2(a[nf][2], a[nf][3]); *(u32x2*)(dst + nb + 16 * nf) = o; }
    }
};
template <int UP>
__device__ void phase_moe(const Params& p, int l, char* lds) {
    int* ps = (int*)(lds + GEMM_LDS);
    int* cn = ps + 40;
    __syncthreads();
    load_pad_start(p, l, ps);
    if (threadIdx.x < NEXP) cn[threadIdx.x] = ((const int*)(p.ws + OFF_CNT))[l * NEXP + threadIdx.x];
    __syncthreads();
    const int total_mt = ps[NEXP] / 128;
    constexpr int NNT = UP ? (2 * EH / GBN) : (D / GBN);
    for (int it = blockIdx.x; it < total_mt * NNT; it += gridDim.x) {
        const int mt = it / NNT, tn = it % NNT;
        int e = 0;
        while (e < NEXP - 1 && ps[e + 1] <= mt * 128) ++e;
        const int cnt = cn[e], row0 = ps[e], mb = mt * 128 - row0;
        if (UP) {
            RowList rl{(const int*)(p.ws + OFF_LIST) + (size_t)e * NT, cnt, 0};
            EpiUp epi{(bf16_t*)(p.ws + OFF_ACT), row0, cnt, 0};
            gemm_tile((const bf16_t*)(p.ws + OFF_H), D, rl, (const bf16_t*)(p.ws + OFF_WUP) + ((size_t)l * NEXP + e) * 2 * EH * D, D, D, mb, tn * GBN, 2 * EH, epi, lds);
        } else {
            struct RowAct { int row0, cnt; __device__ __forceinline__ int operator()(int m) const { return row0 + (m < cnt ? m : cnt - 1); } } ra{row0, cnt};
            EpiDown epi{(bf16_t*)(p.ws + OFF_Y), row0, cnt, 0};
            gemm_tile((const bf16_t*)(p.ws + OFF_ACT), EH, ra, (const bf16_t*)(p.ws + OFF_WDN) + ((size_t)l * NEXP + e) * D * EH, EH, EH, mb, tn * GBN, D, epi, lds);
        }
    }
}

constexpr int ALD = 72;
template <int NMAP, int DV> struct AttnLds { static constexpr int K_BYTES = NMAP * 64 * ALD * 2, V_BYTES = DV * ALD * 2, Q_BYTES = NMAP * (NMAP == 2 ? 128 : 256) * ALD * 2, TOTAL = K_BYTES + V_BYTES + Q_BYTES; };

struct MaskNone { __device__ __forceinline__ bool tile_valid(int) const { return true; } __device__ __forceinline__ float operator()(float s, int, int) const { return s; } };
struct MaskNA {
    const float* bias;
    int rq, cq, rs, rlo;
    __device__ __forceinline__ bool tile_valid(int kt) const { if (kt < LC) return true; const int kr = rlo + kt - LC; return kr >= rs && kr < rs + 8; }
    __device__ __forceinline__ float operator()(float s, int kt, int kc) const {
        if (kt < LC) return s;
        const int kr = rlo + kt - LC;
        int cs = cq - 8; cs = cs < 0 ? 0 : (cs > 48 ? 48 : cs);
        if (kc < cs || kc >= cs + 16) return -INFINITY;
        int dc = kc - cq; dc = dc < -15 ? -15 : (dc > 15 ? 15 : dc);
        return s + bias[(kr - rq + 7) * 31 + dc + 15];
    }
};

template <int NMAP, int DV, class KTok, class MaskF>
__device__ void attn_item(const Params& p, char* lds, int q0, int nq, int nkt, KTok ktok, int qcol, int kcol, int vcol, int ocol, MaskF mask,
                          float lam, const float* g_sub, float post_scale) {
    const bf16_t* P = (const bf16_t*)(p.ws + OFF_P);
    bf16_t* MIX = (bf16_t*)(p.ws + OFF_MIX);
    typedef AttnLds<NMAP, DV> LL;
    constexpr int QPB = NMAP == 2 ? 128 : 256;
    bf16_t* Ks = (bf16_t*)lds; bf16_t* Vt = (bf16_t*)(lds + LL::K_BYTES); bf16_t* Qs = (bf16_t*)(lds + LL::K_BYTES + LL::V_BYTES);
    const int tid = threadIdx.x, lane = tid & 63, wave = tid >> 6, r32 = lane & 31, hh = lane >> 5;
    const int mw = NMAP == 2 ? (wave & 1) : 0, qg = NMAP == 2 ? (wave >> 1) : wave;
    const bool active = qg * 32 < nq;
    __syncthreads();
    for (int c = tid; c < NMAP * QPB * 8; c += NTHREADS) {
        const int ch = c & 7, row = (c >> 3) % QPB, m = (c >> 3) / QPB;
        u32x4 v = {0u, 0u, 0u, 0u};
        if (row < nq) v = *(const u32x4*)(P + (size_t)(q0 + row) * PW + qcol + m * 64 + ch * 8);
        *(u32x4*)(Qs + (m * QPB + row) * ALD + ch * 8) = v;
    }
    constexpr int NDB = DV / 32;
    f32x16 O[NDB];
    float mrun = -1e30f, lrun = 0.f;
#pragma unroll
    for (int d = 0; d < NDB; ++d)
#pragma unroll
        for (int i = 0; i < 16; ++i) O[d][i] = 0.f;
    for (int kt = 0; kt < nkt; ++kt) {
        const int kt0 = ktok(kt);
        __syncthreads();
        for (int c = tid; c < NMAP * 64 * 8; c += NTHREADS) {
            const int ch = c & 7, row = (c >> 3) & 63, m = c >> 9;
            *(u32x4*)(Ks + (m * 64 + row) * ALD + ch * 8) = *(const u32x4*)(P + (size_t)(kt0 + row) * PW + kcol + m * 64 + ch * 8);
        }
        for (int c = tid; c < 64 * (DV / 8); c += NTHREADS) {
            const int ch = c % (DV / 8), row = c / (DV / 8);
            const u32x4 v = *(const u32x4*)(P + (size_t)(kt0 + row) * PW + vcol + ch * 8);
#pragma unroll
            for (int j = 0; j < 4; ++j) { Vt[(ch * 8 + 2 * j) * ALD + row] = (bf16_t)(v[j] & 0xffffu); Vt[(ch * 8 + 2 * j + 1) * ALD + row] = (bf16_t)(v[j] >> 16); }
        }
        __syncthreads();
        if (!active || !mask.tile_valid(kt)) continue;
#pragma unroll
        for (int kb = 0; kb < 2; ++kb) {
            f32x16 st;
#pragma unroll
            for (int i = 0; i < 16; ++i) st[i] = 0.f;
#pragma unroll
            for (int ks = 0; ks < 4; ++ks) {
                const bf16x8 a = *(const bf16x8*)(Ks + (mw * 64 + kb * 32 + r32) * ALD + ks * 16 + hh * 8);
                const bf16x8 b = *(const bf16x8*)(Qs + (mw * QPB + qg * 32 + r32) * ALD + ks * 16 + hh * 8);
                st = MFMA32(a, b, st);
            }
            float mx = -INFINITY;
#pragma unroll
            for (int i = 0; i < 16; ++i) { const int kc = kb * 32 + (i & 3) + 8 * (i >> 2) + 4 * hh; const float sv = mask(st[i], kt, kc); st[i] = sv; mx = fmaxf(mx, sv); }
            mx = fmaxf(mx, __shfl_xor(mx, 32));
            const float mnew = fmaxf(mrun, mx);
            const float alpha = EXP2F(mrun - mnew);
            mrun = mnew;
            float ls = 0.f;
            bf16x8 pf[2];
#pragma unroll
            for (int s2 = 0; s2 < 2; ++s2) {
                u32x4 pk;
#pragma unroll
                for (int j = 0; j < 4; ++j) { const float p0 = EXP2F(st[8 * s2 + 2 * j] - mnew), p1 = EXP2F(st[8 * s2 + 2 * j + 1] - mnew); ls += p0 + p1; pk[j] = pack2(p0, p1); }
                pf[s2] = __builtin_bit_cast(bf16x8, pk);
            }
            lrun = lrun * alpha + ls;
#pragma unroll
            for (int d = 0; d < NDB; ++d) {
#pragma unroll
                for (int i = 0; i < 16; ++i) O[d][i] *= alpha;
#pragma unroll
                for (int s2 = 0; s2 < 2; ++s2) {
                    const bf16_t* vp = Vt + (d * 32 + r32) * ALD + kb * 32 + s2 * 16 + 4 * hh;
                    const u32x2 lo = *(const u32x2*)vp, hi = *(const u32x2*)(vp + 8);
                    const u32x4 av = {lo[0], lo[1], hi[0], hi[1]};
                    O[d] = MFMA32(__builtin_bit_cast(bf16x8, av), pf[s2], O[d]);
                }
            }
        }
    }
    __syncthreads();
    float inv = 1.0f;
    if (active) { const float lt = lrun + __shfl_xor(lrun, 32); inv = 1.0f / lt; }
    float* ex = (float*)lds;
    if (NMAP == 2) {
        if (active && mw == 1) {
#pragma unroll
            for (int d = 0; d < NDB; ++d)
#pragma unroll
                for (int i = 0; i < 16; ++i) ex[((qg * NDB + d) * 16 + i) * 64 + lane] = O[d][i] * inv * lam;
        }
        __syncthreads();
    }
    if (active && mw == 0) {
        float ss = 0.f;
#pragma unroll
        for (int d = 0; d < NDB; ++d)
#pragma unroll
            for (int i = 0; i < 16; ++i) {
                float o = O[d][i] * inv;
                if (NMAP == 2) o -= ex[((qg * NDB + d) * 16 + i) * 64 + lane];
                O[d][i] = o; ss += o * o;
            }
        float rs = 1.0f;
        if (NMAP == 2) { ss += __shfl_xor(ss, 32); rs = post_scale / sqrtf(ss / (float)DV + NORM_EPS); }
        const int tok = q0 + qg * 32 + r32;
#pragma unroll
        for (int d = 0; d < NDB; ++d)
#pragma unroll
            for (int g = 0; g < 4; ++g) {
                const int dd = d * 32 + 8 * g + 4 * hh;
                float v0 = O[d][4 * g] * rs, v1 = O[d][4 * g + 1] * rs, v2 = O[d][4 * g + 2] * rs, v3 = O[d][4 * g + 3] * rs;
                if (NMAP == 2) { v0 *= g_sub[dd]; v1 *= g_sub[dd + 1]; v2 *= g_sub[dd + 2]; v3 *= g_sub[dd + 3]; }
                u32x2 o; o[0] = pack2(v0, v1); o[1] = pack2(v2, v3);
                *(u32x2*)(MIX + (size_t)tok * MIXW + ocol + dd) = o;
            }
    }
}

struct KTokDiff { int b; __device__ __forceinline__ int operator()(int kt) const { return kt < LC ? NL + b * L + kt * 64 : b * S + (kt - LC) * 64; } };
struct KTokCtx { int b; __device__ __forceinline__ int operator()(int kt) const { return NL + b * L + kt * 64; } };
struct KTokNA { int b, rlo; __device__ __forceinline__ int operator()(int kt) const { return kt < LC ? NL + b * L + kt * 64 : b * S + (rlo + kt - LC) * 64; } };

__device__ void gla_decay(const Params& p, int l, int h, int tok0, float* bcum  , float* wd  ) {
    const int tid = threadIdx.x;
    const bf16_t* P = (const bf16_t*)(p.ws + OFF_P);
    for (int e = tid; e < 2 * 16 * 32; e += NTHREADS) { const int d = e >> 9, r = (e >> 5) & 15, k = e & 31; wd[e] = p.w_dec[(((size_t)l * 2 + d) * 16 + r) * 128 + h * 32 + k]; }
    if (tid < 64) { const int d = tid >> 5, k = tid & 31; wd[1024 + tid] = p.b_dec[((size_t)l * 2 + d) * 128 + h * 32 + k]; }
    __syncthreads();
    for (int e = tid; e < 2 * 64 * 32; e += NTHREADS) {
        const int d = e >> 11, t = (e >> 5) & 63, k = e & 31;
        float z = wd[1024 + d * 32 + k];
        const bf16_t* g = P + (size_t)(tok0 + t) * PW + C_GB + d * 16;
#pragma unroll
        for (int r = 0; r < 16; ++r) z += bf2f(g[r]) * wd[(d * 16 + r) * 32 + k];
        bcum[e] = log_sigmoidf(z) * (1.0f / 16.0f);
    }
    __syncthreads();
    if (tid < 64) {
        const int d = tid >> 5, k = tid & 31; float a = 0.f;
        if (d == 0) { for (int t = 0; t < 64; ++t) { a += bcum[(t) * 32 + k]; bcum[t * 32 + k] = a; } }
        else { for (int t = 63; t >= 0; --t) { a += bcum[2048 + t * 32 + k]; bcum[2048 + t * 32 + k] = a; } }
    }
    __syncthreads();
}
__device__ __forceinline__ int gla_chunk_tok(int b, int c) { return c < LC ? NL + b * L + c * 64 : b * S + (c - LC) * 64; }

__device__ void phase_gla_local(const Params& p, int l, char* lds) {
    float* bcum = (float*)lds;
    float* wd = bcum + 4096;
    float* kw = wd + 1088;
    float* vs = kw + 4096;
    const int tid = threadIdx.x;
    const bf16_t* P = (const bf16_t*)(p.ws + OFF_P);
    float* GKV = (float*)(p.ws + OFF_GKV); float* GDEC = (float*)(p.ws + OFF_GDEC);
    for (int it = blockIdx.x; it < NB * 4 * NCH; it += gridDim.x) {
        const int c = it % NCH, h = (it / NCH) & 3, b = it / (NCH * 4);
        const int tok0 = gla_chunk_tok(b, c);
        __syncthreads();
        gla_decay(p, l, h, tok0, bcum, wd);
        for (int e = tid; e < 2 * 64 * 32; e += NTHREADS) {
            const int d = e >> 11, t = (e >> 5) & 63, k = e & 31;
            const float kv = bf2f(P[(size_t)(tok0 + t) * PW + C_KB + h * 32 + k]);
            const float bend = d == 0 ? bcum[63 * 32 + k] : bcum[2048 + k];
            kw[e] = kv * expf(bend - bcum[e]);
        }
        for (int e = tid; e < 64 * 64; e += NTHREADS) { const int t = e >> 6, v = e & 63; vs[e] = bf2f(P[(size_t)(tok0 + t) * PW + C_VB + h * 64 + v]); }
        __syncthreads();
        const size_t base = (((size_t)(b * 4 + h) * 2) * NCH + c);
#pragma unroll
        for (int i = 0; i < 8; ++i) {
            const int e = tid + i * NTHREADS, d = e >> 11, k = (e >> 6) & 31, v = e & 63;
            float a = 0.f;
            for (int t = 0; t < 64; ++t) a += kw[d * 2048 + t * 32 + k] * vs[t * 64 + v];
            GKV[(base + (size_t)d * NCH) * 2048 + k * 64 + v] = a;
        }
        if (tid < 64) { const int d = tid >> 5, k = tid & 31; GDEC[(base + (size_t)d * NCH) * 32 + k] = expf(d == 0 ? bcum[63 * 32 + k] : bcum[2048 + k]); }
    }
}
__device__ void phase_gla_scan(const Params& p) {
    float* GKV = (float*)(p.ws + OFF_GKV); const float* GDEC = (const float*)(p.ws + OFF_GDEC);
    const int total = NB * 4 * 2 * 2048;
    for (int e = blockIdx.x * NTHREADS + threadIdx.x; e < total; e += gridDim.x * NTHREADS) {
        const int el = e & 2047, chain = e >> 11, d = chain & 1, k = el >> 6;
        float* kv = GKV + (size_t)chain * NCH * 2048 + el; const float* dec = GDEC + (size_t)chain * NCH * 32 + k;
        float s = 0.f;
        for (int i = 0; i < NCH; ++i) {
            int c;
            if (d == 0) c = i; else c = i < LC ? LC - 1 - i : NCH - 1 - (i - LC);
            const float a = kv[(size_t)c * 2048], dc = dec[(size_t)c * 32];
            kv[(size_t)c * 2048] = s;
            s = dc * s + a;
        }
    }
}
__device__ void gla_out_item(const Params& p, int l, int b, int h, int c, char* lds) {
    float* bcum = (float*)lds;
    float* wd = bcum + 4096;
    float* qs = wd + 1088;
    float* ksr = qs + 2048;
    float* vs = ksr + 2048;
    float* qe = vs + 4096;
    float* ke = qe + 2048;
    float* qf = ke + 2048;
    float* Am = qf + 2048;
    float* Sm = Am + 4096;
    const int tid = threadIdx.x;
    const bf16_t* P = (const bf16_t*)(p.ws + OFF_P);
    const float* GKV = (const float*)(p.ws + OFF_GKV);
    const int tok0 = gla_chunk_tok(b, c);
    __syncthreads();
    gla_decay(p, l, h, tok0, bcum, wd);
    for (int e = tid; e < 64 * 32; e += NTHREADS) { const int t = e >> 5, k = e & 31;
        qs[e] = bf2f(P[(size_t)(tok0 + t) * PW + C_QB + h * 32 + k]); ksr[e] = bf2f(P[(size_t)(tok0 + t) * PW + C_KB + h * 32 + k]); }
    for (int e = tid; e < 64 * 64; e += NTHREADS) { const int t = e >> 6, v = e & 63; vs[e] = bf2f(P[(size_t)(tok0 + t) * PW + C_VB + h * 64 + v]); }
    const int t_o = tid >> 3, v0 = (tid & 7) * 8;
    float o[8];
#pragma unroll
    for (int j = 0; j < 8; ++j) o[j] = 0.f;
    for (int d = 0; d < 2; ++d) {
        __syncthreads();
        const float* bc = bcum + d * 2048;
        for (int e = tid; e < 64 * 32; e += NTHREADS) { const int t = e >> 5, k = e & 31; const float bt = bc[e], br = bc[32 * 32 + k];
            qe[e] = qs[e] * expf(bt - br); ke[e] = ksr[e] * expf(br - bt); qf[e] = qs[e] * expf(bt); }
        const float* sin_ = GKV + ((((size_t)(b * 4 + h) * 2 + d) * NCH + c)) * 2048;
        for (int e = tid; e < 2048; e += NTHREADS) Sm[e] = sin_[e];
        __syncthreads();
#pragma unroll
        for (int i = 0; i < 8; ++i) { const int e = tid + i * NTHREADS, t = e >> 6, s = e & 63;
            float a = 0.f;
            const bool ok = d == 0 ? (s <= t) : (s >= t);
            if (ok) { for (int k = 0; k < 32; ++k) a += qe[t * 32 + k] * ke[s * 32 + k]; }
            Am[e] = a; }
        __syncthreads();
        for (int s = 0; s < 64; ++s) { const float a = Am[t_o * 64 + s];
#pragma unroll
            for (int j = 0; j < 8; ++j) o[j] += a * vs[s * 64 + v0 + j]; }
        for (int k = 0; k < 32; ++k) { const float a = qf[t_o * 32 + k];
#pragma unroll
            for (int j = 0; j < 8; ++j) o[j] += a * Sm[k * 64 + v0 + j]; }
    }
    float ss = 0.f;
#pragma unroll
    for (int j = 0; j < 8; ++j) ss += o[j] * o[j];
    ss += __shfl_xor(ss, 1); ss += __shfl_xor(ss, 2); ss += __shfl_xor(ss, 4);
    const float rstd = 1.0f / sqrtf(ss / 64.0f + NORM_EPS);
    const int tok = tok0 + t_o;
    bf16_t* MIX = (bf16_t*)(p.ws + OFF_MIX);
    const bf16_t* rg = P + (size_t)tok * PW + C_RB + h * 64 + v0;
    float r[8];
#pragma unroll
    for (int j = 0; j < 8; ++j) r[j] = o[j] * rstd * p.g_gla[l * 64 + v0 + j] * siluf(bf2f(rg[j]));
    u32x4 ov = {pack2(r[0], r[1]), pack2(r[2], r[3]), pack2(r[4], r[5]), pack2(r[6], r[7])};
    *(u32x4*)(MIX + (size_t)tok * MIXW + 512 + h * 64 + v0) = ov;
}

__device__ void phase_mixers(const Params& p, int l, char* lds) {
    const bool need_ctx = l < DEPTH - 1;
    const float lam_init = 0.8f - 0.6f * expf(-0.3f * (float)l);
    float lam_val;
    { const float* lm = p.lam + (size_t)l * 4 * 64; float a = 0.f, b2 = 0.f; for (int i = 0; i < 64; ++i) { a += lm[i] * lm[64 + i]; b2 += lm[128 + i] * lm[192 + i]; } lam_val = expf(a) - expf(b2) + lam_init; }
    constexpr int QB_PER = S / 128, QC_PER = L / 128;
    constexpr int N_DIFF = NB * 4 * QB_PER, N_DIFFC = NB * 4 * QC_PER;
    constexpr int NA_BLK = IMG_ROWS / 4;
    constexpr int N_NA = NB * 4 * NA_BLK, N_NAC = NB * 4;
    constexpr int N_GLA = NB * 4 * NCH;
    const int n_gla = need_ctx ? N_GLA : N_GLA;
    const int i1 = N_DIFF, i2 = i1 + (need_ctx ? N_DIFFC : 0), i3 = i2 + N_NA, i4 = i3 + (need_ctx ? N_NAC : 0), i5 = i4 + n_gla;
    const float* gsub = p.g_sub + (size_t)l * 128;
    const int G = gridDim.x, bid = blockIdx.x;
    auto first = [&](int a) { return a + ((bid - a % G + G) % G); };
    for (int it = first(0); it < i1; it += G) {
        const int qb = it % QB_PER, h = (it / QB_PER) & 3, b = it / (QB_PER * 4);
        attn_item<2, 128>(p, lds, b * S + qb * 128, 128, NCH, KTokDiff{b}, C_QA + h * 128, C_KA + h * 128, C_VA + h * 128, h * 128, MaskNone(), lam_val, gsub, 1.0f - lam_init);
    }
    for (int it = first(i1); it < i2; it += G) {
        const int j = it - i1, qb = j % QC_PER, h = (j / QC_PER) & 3, b = j / (QC_PER * 4);
        attn_item<2, 128>(p, lds, NL + b * L + qb * 128, 128, LC, KTokCtx{b}, C_QA + h * 128, C_KA + h * 128, C_VA + h * 128, h * 128, MaskNone(), lam_val, gsub, 1.0f - lam_init);
    }
    for (int it = first(i2); it < i3; it += G) {
        const int j = it - i2, rb = j % NA_BLK, h = (j / NA_BLK) & 3, b = j / (NA_BLK * 4);
        const int r0 = rb * 4;
        auto rstart = [](int r) { int s = r - 4; return s < 0 ? 0 : (s > IMG_ROWS - 8 ? IMG_ROWS - 8 : s); };
        const int rlo = rstart(r0), rhi = rstart(r0 + 3) + 7;
        float* bias = (float*)(lds + AttnLds<1, 64>::TOTAL);
        __syncthreads();
        for (int e = threadIdx.x; e < 15 * 31; e += NTHREADS) bias[e] = p.rpb[((size_t)l * 4 + h) * 15 * 31 + e] * LOG2E;
        const int wave = threadIdx.x >> 6, lane = threadIdx.x & 63;
        const int rq = r0 + (wave >> 1), cq = (wave & 1) * 32 + (lane & 31);
        MaskNA mk{bias, rq, cq, rstart(rq), rlo};
        attn_item<1, 64>(p, lds, b * S + r0 * 64, 256, LC + (rhi - rlo + 1), KTokNA{b, rlo}, C_QN + h * 64, C_KN + h * 64, C_VN + h * 64, 768 + h * 64, mk, 0.f, nullptr, 1.0f);
    }
    for (int it = first(i3); it < i4; it += G) {
        const int j = it - i3, h = j & 3, b = j >> 2;
        attn_item<1, 64>(p, lds, NL + b * L, L, LC, KTokCtx{b}, C_QN + h * 64, C_KN + h * 64, C_VN + h * 64, 768 + h * 64, MaskNone(), 0.f, nullptr, 1.0f);
    }
    for (int it = first(i4); it < i5; it += G) {
        const int j = it - i4, c = j % NCH, h = (j / NCH) & 3, b = j / (NCH * 4);
        gla_out_item(p, l, b, h, c, lds);
    }
}

constexpr int cmax(int a, int b) { return a > b ? a : b; }
constexpr int LDS_BYTES = cmax(cmax(GEMM_LDS + 512, AttnLds<2, 128>::TOTAL), cmax(256 + 36 * D * 4 + 2048, cmax(AttnLds<1, 64>::TOTAL + 2048, 27776 * 4))) + 16;

#ifndef MK_LAUNCHES
#define MK_LAUNCHES 0
#endif
template <int PT> __device__ __forceinline__ void run_phase(const Params& p, int l, char* lds) {
    if (PT == 0) phase_prologue(p, lds);
    if (PT == 1) phase_norm<0>(p, l, lds);
    if (PT == 2) phase_gemm_in(p, l, lds);
    if (PT == 3) phase_gla_local(p, l, lds);
    if (PT == 4) phase_gla_scan(p);
    if (PT == 5) phase_mixers(p, l, lds);
    if (PT == 6) phase_gemm_out(p, l, lds);
    if (PT == 7) phase_norm<1>(p, l, lds);
    if (PT == 8) phase_moe<1>(p, l, lds);
    if (PT == 9) phase_moe<0>(p, l, lds);
    if (PT == 10) phase_norm<2>(p, 0, lds);
}
template <int PT> __global__ void __launch_bounds__(NTHREADS, 2) k_phase(Params p, int l) {
    DYN_LDS(lds_raw);
    run_phase<PT>(p, l, lds_raw + 16);
}

#if MK_LAUNCHES == 1
__global__ void __launch_bounds__(NTHREADS, 2) mega(Params p) {
    DYN_LDS(lds_raw);
    char* lds = lds_raw + 16;
#ifdef EMU
    GridBar gb{(unsigned*)(p.ws + OFF_BAR)};
#else
    if (threadIdx.x == 0) *(uint4*)lds_raw = make_uint4(0u, 0u, 0u, 0u);
    __syncthreads();
    GridBar gb = xcd_barrier_post((unsigned*)(p.ws + OFF_BAR), (volatile LAS unsigned*)lds_raw);
#endif
    run_phase<0>(p, 0, lds); grid_barrier(gb);
    for (int l = 0; l < DEPTH; ++l) {
        run_phase<1>(p, l, lds); grid_barrier(gb);
        run_phase<2>(p, l, lds); grid_barrier(gb);
        run_phase<3>(p, l, lds); grid_barrier(gb);
        run_phase<4>(p, l, lds); grid_barrier(gb);
        run_phase<5>(p, l, lds); grid_barrier(gb);
        run_phase<6>(p, l, lds); grid_barrier(gb);
        run_phase<7>(p, l, lds); grid_barrier(gb);
        run_phase<8>(p, l, lds); grid_barrier(gb);
        run_phase<9>(p, l, lds); grid_barrier(gb);
    }
    run_phase<10>(p, 0, lds);
}
#endif


extern "C" void kernel_launch(void* const* d_in, const int* in_sizes, int n_in, void* d_out, int out_size, void* d_ws, size_t ws_size, hipStream_t stream) {
    (void)in_sizes; (void)n_in; (void)out_size; (void)ws_size;
    Params p;
    p.x = (const float*)d_in[0]; p.c = (const float*)d_in[1]; p.ctx = (const float*)d_in[2]; p.c_ctx = (const float*)d_in[3];
    p.w_mod = (const float*)d_in[4]; p.b_mod = (const float*)d_in[5]; p.g1 = (const float*)d_in[6]; p.g2 = (const float*)d_in[7];
    p.w_in = (const float*)d_in[8]; p.w_out = (const float*)d_in[9]; p.lam = (const float*)d_in[10]; p.g_sub = (const float*)d_in[11];
    p.w_dec = (const float*)d_in[12]; p.b_dec = (const float*)d_in[13]; p.g_gla = (const float*)d_in[14]; p.rpb = (const float*)d_in[15];
    p.w_rg = (const float*)d_in[16]; p.b_rg = (const float*)d_in[17]; p.w_re = (const float*)d_in[18]; p.b_re = (const float*)d_in[19];
    p.w_up = (const float*)d_in[20]; p.w_dn = (const float*)d_in[21]; p.g_fin = (const float*)d_in[22];
    p.out = (float*)d_out; p.ws = (char*)d_ws;
    (void)hipMemsetAsync(d_ws, 0, ZERO_BYTES, stream);
#ifdef EMU
    const int grid = emu::g_max_os_threads;
#define LAUNCH_PH(PT, l) do { auto t0 = std::chrono::steady_clock::now(); EMU_LAUNCH(k_phase<PT>, grid, NTHREADS, LDS_BYTES, stream, p, l); \
        fprintf(stderr, "  phase type %d layer %d: %.2f s\n", PT, l, std::chrono::duration<double>(std::chrono::steady_clock::now() - t0).count()); } while (0)
#if MK_LAUNCHES == 1
#define LAUNCH_MEGA() EMU_LAUNCH(mega, grid, NTHREADS, LDS_BYTES, stream, p)
#else
#define LAUNCH_MEGA() do {} while (0)
#endif
    const int hi = getenv("EMU_PH_HI") ? atoi(getenv("EMU_PH_HI")) : 1000;
#else
    static int grid = 0;
    if (!grid) {
        int dev = 0, cus = 0, per_cu = 0;
        (void)hipGetDevice(&dev);
        (void)hipDeviceGetAttribute(&cus, hipDeviceAttributeMultiprocessorCount, dev);
#if MK_LAUNCHES == 1
        (void)hipFuncSetAttribute((const void*)mega, hipFuncAttributeMaxDynamicSharedMemorySize, LDS_BYTES);
#endif
        (void)hipFuncSetAttribute((const void*)k_phase<0>, hipFuncAttributeMaxDynamicSharedMemorySize, LDS_BYTES);
        (void)hipFuncSetAttribute((const void*)k_phase<1>, hipFuncAttributeMaxDynamicSharedMemorySize, LDS_BYTES);
        (void)hipFuncSetAttribute((const void*)k_phase<2>, hipFuncAttributeMaxDynamicSharedMemorySize, LDS_BYTES);
        (void)hipFuncSetAttribute((const void*)k_phase<3>, hipFuncAttributeMaxDynamicSharedMemorySize, LDS_BYTES);
        (void)hipFuncSetAttribute((const void*)k_phase<4>, hipFuncAttributeMaxDynamicSharedMemorySize, LDS_BYTES);
        (void)hipFuncSetAttribute((const void*)k_phase<5>, hipFuncAttributeMaxDynamicSharedMemorySize, LDS_BYTES);
        (void)hipFuncSetAttribute((const void*)k_phase<6>, hipFuncAttributeMaxDynamicSharedMemorySize, LDS_BYTES);
        (void)hipFuncSetAttribute((const void*)k_phase<7>, hipFuncAttributeMaxDynamicSharedMemorySize, LDS_BYTES);
        (void)hipFuncSetAttribute((const void*)k_phase<8>, hipFuncAttributeMaxDynamicSharedMemorySize, LDS_BYTES);
        (void)hipFuncSetAttribute((const void*)k_phase<9>, hipFuncAttributeMaxDynamicSharedMemorySize, LDS_BYTES);
        (void)hipFuncSetAttribute((const void*)k_phase<10>, hipFuncAttributeMaxDynamicSharedMemorySize, LDS_BYTES);
        (void)hipOccupancyMaxActiveBlocksPerMultiprocessor(&per_cu, k_phase<5>, NTHREADS, LDS_BYTES);
        grid = cus * (per_cu < 1 ? per_cu : 1);
        if (grid <= 0) grid = cus;
    }
#define LAUNCH_PH(PT, l) hipLaunchKernelGGL(k_phase<PT>, dim3(grid), dim3(NTHREADS), LDS_BYTES, stream, p, l)
#if MK_LAUNCHES == 1
#define LAUNCH_MEGA() hipLaunchKernelGGL(mega, dim3(grid), dim3(NTHREADS), LDS_BYTES, stream, p)
#else
#define LAUNCH_MEGA() do {} while (0)
#endif
    const int hi = 1000;
#endif
    if (MK_LAUNCHES == 1) { LAUNCH_MEGA(); }
    else {
        int ph = 0;
#define STEP(PT, l) do { if (ph++ < hi) LAUNCH_PH(PT, l); } while (0)
        STEP(0, 0);
        for (int l = 0; l < DEPTH; ++l) { STEP(1, l); STEP(2, l); STEP(3, l); STEP(4, l); STEP(5, l); STEP(6, l); STEP(7, l); STEP(8, l); STEP(9, l); }
        STEP(10, 0);
    }
}

#ifdef EMU
#include <string>
static void dump_file(const std::string& path, const void* ptr, size_t bytes) { FILE* f = fopen(path.c_str(), "wb"); fwrite(ptr, 1, bytes, f); fclose(f); }
extern "C" void emu_debug_dump(void* d_ws, const char* dir) {
    char* ws = (char*)d_ws; std::string d(dir);
    dump_file(d + "/ws_X.bin", ws + OFF_X, (size_t)NT * D * 4);
    dump_file(d + "/ws_H.bin", ws + OFF_H, (size_t)NT * D * 2);
    dump_file(d + "/ws_P.bin", ws + OFF_P, (size_t)NT * PW * 2);
    dump_file(d + "/ws_MIX.bin", ws + OFF_MIX, (size_t)NT * MIXW * 2);
    dump_file(d + "/ws_MOD.bin", ws + OFF_MOD, (size_t)DEPTH * (NB + 1) * 6 * D * 4);
    dump_file(d + "/ws_ROUTE.bin", ws + OFF_ROUTE, (size_t)NT * 32);
}
#endif
```

```cpp
#ifndef EMU
#include <hip/hip_runtime.h>
#endif
#include <stdint.h>
#include <stddef.h>
#include <math.h>

#ifdef EMU
#include <chrono>
#ifndef E_D
#define E_D 256
#define E_B 2
#define E_S 1024
#define E_DEPTH 2
#define E_L 128
#define E_EH 256
#endif
constexpr int D = E_D, NB = E_B, S = E_S, DEPTH = E_DEPTH, L = E_L, EH = E_EH;
#else
constexpr int D = 1024, NB = 8, S = 4096, DEPTH = 4, L = 256, EH = 512;
#endif
constexpr int NL = NB * S, NC = NB * L, NT = NL + NC;
constexpr int IMG_ROWS = S / 64;
constexpr int PW = 3104;
constexpr int C_QA = 0, C_KA = 512, C_VA = 1024, C_QB = 1536, C_KB = 1664, C_VB = 1792, C_RB = 2048, C_GB = 2304, C_QN = 2336, C_KN = 2592, C_VN = 2848;
constexpr int MIXW = 1024;
constexpr int NEXP = 32;
constexpr int LC = L / 64, SC = S / 64, NCH = LC + SC;
constexpr int NTHREADS = 512;
constexpr float LOG2E = 1.4426950408889634f;
constexpr float NORM_EPS = 1e-6f;
constexpr int YROWS = 2 * NT + NEXP * 256;

typedef unsigned short bf16_t;
typedef short bf16x8 __attribute__((ext_vector_type(8)));
typedef short bf16x4 __attribute__((ext_vector_type(4)));
typedef float f32x4 __attribute__((ext_vector_type(4)));
typedef float f32x16 __attribute__((ext_vector_type(16)));
typedef unsigned u32x4 __attribute__((ext_vector_type(4)));
typedef unsigned u32x2 __attribute__((ext_vector_type(2)));

#ifdef EMU
#define MFMA32(a, b, c) emu_mfma32(a, b, c)
#define MFMA16(a, b, c) emu_mfma16(a, b, c)
#define MFMA16F32(a, b, c) emu_mfma16f32(a, b, c)
#define WAVE_SYNC() ((void)__ballot(1))
#define DYN_LDS(name) char* name = emu::dyn_lds()
#define EXP2F(x) exp2f(x)
#else
#define MFMA32(a, b, c) __builtin_amdgcn_mfma_f32_32x32x16_bf16(a, b, c, 0, 0, 0)
#define MFMA16(a, b, c) __builtin_amdgcn_mfma_f32_16x16x32_bf16(a, b, c, 0, 0, 0)
#define MFMA16F32(a, b, c) __builtin_amdgcn_mfma_f32_16x16x4f32(a, b, c, 0, 0, 0)
#define WAVE_SYNC() __builtin_amdgcn_wave_barrier()
#define DYN_LDS(name) extern __shared__ __attribute__((aligned(16))) char name[]
#define EXP2F(x) __builtin_amdgcn_exp2f(x)
#endif

#ifdef EMU
#define LAUNDER_S(x) do {} while (0)
#define LAUNDER_GPTR(x) do {} while (0)
#else
#define LAUNDER_S(x) asm volatile("" : "+s"(x))
#define LAUNDER_GPTR(x) do { unsigned long long _v = (unsigned long long)(x); asm volatile("" : "+s"(_v)); (x) = (decltype(x))(__attribute__((address_space(1))) char*)_v; } while (0)
#endif

#ifdef EMU
__device__ __forceinline__ int TID() { return (int)threadIdx.x; }
__device__ __forceinline__ int BID() { return (int)blockIdx.x; }
__device__ __forceinline__ int GDIM() { return (int)gridDim.x; }
#else
__device__ __forceinline__ int TID() { int t = (int)threadIdx.x; asm volatile("" : "+v"(t)); return t; }
__device__ __forceinline__ int BID() { int t = (int)blockIdx.x; asm volatile("" : "+s"(t)); return t; }
__device__ __forceinline__ int GDIM() { int t = (int)gridDim.x; asm volatile("" : "+s"(t)); return t; }
#endif
__device__ __forceinline__ unsigned f2u(float f) { return __builtin_bit_cast(unsigned, f); }
__device__ __forceinline__ float u2f(unsigned u) { return __builtin_bit_cast(float, u); }
__device__ __forceinline__ bf16_t f2bf(float f) { unsigned u = f2u(f); u += 0x7fffu + ((u >> 16) & 1u); return (bf16_t)(u >> 16); }
__device__ __forceinline__ float bf2f(bf16_t h) { return u2f((unsigned)h << 16); }
#ifdef EMU
__device__ __forceinline__ unsigned pack2(float lo, float hi) { return (unsigned)f2bf(lo) | ((unsigned)f2bf(hi) << 16); }
#else
typedef float pk_f2 __attribute__((ext_vector_type(2)));
typedef __bf16 pk_b2 __attribute__((ext_vector_type(2)));
__device__ __forceinline__ unsigned pack2(float lo, float hi) { const pk_f2 v = {lo, hi}; return __builtin_bit_cast(unsigned, __builtin_convertvector(v, pk_b2)); }
#endif
#ifdef EMU
#define LOG2F_FAST(x) log2f(x)
#define RCPF_FAST(x) (1.0f / (x))
#else
#define LOG2F_FAST(x) __builtin_amdgcn_logf(x)
#define RCPF_FAST(x) __builtin_amdgcn_rcpf(x)
#endif
__device__ __forceinline__ float siluf(float x) { return x / (1.0f + expf(-x)); }
__device__ __forceinline__ float exp_fast(float x) { return EXP2F(x * LOG2E); }
__device__ __forceinline__ float silu_fast(float x) { return x * RCPF_FAST(1.0f + EXP2F(-x * LOG2E)); }
__device__ __forceinline__ float log_sigmoid_fast(float x) { return fminf(x, 0.f) - 0.6931471805599453f * LOG2F_FAST(1.0f + EXP2F(-fabsf(x) * LOG2E)); }
__device__ __forceinline__ float log_sigmoidf(float x) { return fminf(x, 0.f) - log1pf(expf(-fabsf(x))); }

#ifdef EMU
__device__ __forceinline__ float xhalf_max(float v) { return fmaxf(v, __shfl_xor(v, 32)); }
__device__ __forceinline__ float xhalf_sum(float v) { return v + __shfl_xor(v, 32); }
#else
__device__ __forceinline__ float xhalf_max(float v) { const auto r = __builtin_amdgcn_permlane32_swap(f2u(v), f2u(v), false, false); return fmaxf(u2f(r[0]), u2f(r[1])); }
__device__ __forceinline__ float xhalf_sum(float v) { const auto r = __builtin_amdgcn_permlane32_swap(f2u(v), f2u(v), false, false); return u2f(r[0]) + u2f(r[1]); }
#endif
__device__ __forceinline__ float wave_sum(float v) {
#pragma unroll
    for (int m = 32; m >= 1; m >>= 1) v += __shfl_xor(v, m);
    return v;
}

constexpr size_t al256(size_t x) { return (x + 255) & ~(size_t)255; }
constexpr size_t BAR_BYTES = 16384;
constexpr size_t OFF_BAR = 0;
constexpr size_t OFF_CNT = OFF_BAR + BAR_BYTES;
constexpr size_t ZERO_BYTES = OFF_CNT + 4096;
constexpr size_t OFF_ROPE = ZERO_BYTES;
constexpr size_t OFF_MOD = OFF_ROPE + 8192;
constexpr size_t OFF_WIN = al256(OFF_MOD + (size_t)DEPTH * 9 * 6 * D * 4);
constexpr size_t OFF_WOUT = al256(OFF_WIN + (size_t)DEPTH * 3328 * D * 2);
constexpr size_t OFF_WUP = al256(OFF_WOUT + (size_t)DEPTH * D * MIXW * 2);
constexpr size_t OFF_WDN = al256(OFF_WUP + (size_t)DEPTH * NEXP * 2 * EH * D * 2);
constexpr size_t OFF_X = al256(OFF_WDN + (size_t)DEPTH * NEXP * D * EH * 2);
constexpr size_t OFF_H = al256(OFF_X + (size_t)NT * D * 4);
constexpr size_t OFF_P = al256(OFF_H + (size_t)NT * D * 2);
constexpr size_t OFF_MIX = al256(OFF_P + (size_t)NT * PW * 2);
constexpr size_t OFF_GKV = al256(OFF_MIX + (size_t)NT * MIXW * 2);
constexpr size_t OFF_GDEC = al256(OFF_GKV + (size_t)NB * 4 * 2 * NCH * 4096 * 4);
constexpr size_t OFF_ROUTE = al256(OFF_GDEC + (size_t)NB * 4 * 2 * NCH * 32 * 4);
constexpr size_t OFF_LIST = al256(OFF_ROUTE + (size_t)NT * 32);
constexpr size_t OFF_ACT = al256(OFF_LIST + (size_t)NEXP * NT * 4);
constexpr size_t OFF_Y = al256(OFF_ACT + (size_t)YROWS * EH * 2);
constexpr size_t OFF_S_G1 = al256(OFF_Y + (size_t)YROWS * D * 2); constexpr size_t N_S_G1 = (size_t)(DEPTH * D);
constexpr size_t OFF_S_G2 = al256(OFF_S_G1 + N_S_G1 * 4); constexpr size_t N_S_G2 = (size_t)(DEPTH * D);
constexpr size_t OFF_S_LAM = al256(OFF_S_G2 + N_S_G2 * 4); constexpr size_t N_S_LAM = (size_t)(DEPTH * 256);
constexpr size_t OFF_S_GSUB = al256(OFF_S_LAM + N_S_LAM * 4); constexpr size_t N_S_GSUB = (size_t)(DEPTH * 128);
constexpr size_t OFF_S_WDEC = al256(OFF_S_GSUB + N_S_GSUB * 4); constexpr size_t N_S_WDEC = (size_t)(DEPTH * 2 * 16 * 128);
constexpr size_t OFF_S_BDEC = al256(OFF_S_WDEC + N_S_WDEC * 4); constexpr size_t N_S_BDEC = (size_t)(DEPTH * 2 * 128);
constexpr size_t OFF_S_GGLA = al256(OFF_S_BDEC + N_S_BDEC * 4); constexpr size_t N_S_GGLA = (size_t)(DEPTH * 64);
constexpr size_t OFF_S_RPB = al256(OFF_S_GGLA + N_S_GGLA * 4); constexpr size_t N_S_RPB = (size_t)(DEPTH * 4 * 15 * 31);
constexpr size_t OFF_S_WRG = al256(OFF_S_RPB + N_S_RPB * 4); constexpr size_t N_S_WRG = (size_t)(DEPTH * D * 4);
constexpr size_t OFF_S_BRG = al256(OFF_S_WRG + N_S_WRG * 4); constexpr size_t N_S_BRG = (size_t)(DEPTH * 4);
constexpr size_t OFF_S_WRE = al256(OFF_S_BRG + N_S_BRG * 4); constexpr size_t N_S_WRE = (size_t)(DEPTH * D * 32);
constexpr size_t OFF_S_BRE = al256(OFF_S_WRE + N_S_WRE * 4); constexpr size_t N_S_BRE = (size_t)(DEPTH * 32);
constexpr size_t OFF_S_GFIN = al256(OFF_S_BRE + N_S_BRE * 4); constexpr size_t N_S_GFIN = (size_t)(D);
constexpr size_t OFF_WRT = al256(OFF_S_GFIN + N_S_GFIN * 4);
constexpr size_t OFF_XD = al256(OFF_WRT + (size_t)DEPTH * 48 * D * 4);
constexpr size_t WS_TOTAL = al256(OFF_XD + (size_t)NT * D * 2);

struct PP {
    char* ws; float* out; const float* x; const float* ctx;
    __device__ __forceinline__ const float* sm(size_t off) const { return (const float*)(ws + off); }
};
struct Params {
    const float* x; const float* c; const float* ctx; const float* c_ctx; const float* w_mod; const float* b_mod;
    const float* g1; const float* g2; const float* w_in; const float* w_out; const float* lam; const float* g_sub;
    const float* w_dec; const float* b_dec; const float* g_gla; const float* rpb; const float* w_rg; const float* b_rg;
    const float* w_re; const float* b_re; const float* w_up; const float* w_dn; const float* g_fin;
    float* out; char* ws;
};

#ifdef EMU
struct GridBar { unsigned* ctr; };
__device__ __forceinline__ void grid_barrier(GridBar& gb) { __shared__ unsigned gen; emu_grid_barrier(gb.ctr, gen); }
#else
#define XB_TMO      128
#define XB_XCNT(j)  (256  + 64 * (j))
#define XB_XSUB(j)  (1280 + 64 * (j))
#define XB_XGEN(j)  (2304 + 64 * (j))
#define XB_TOP      3328
#define XB_TOPGEN   3392
#define XCD_BAR_WORDS 3456
#define XB_SPIN_CAP (1u << 22)
#define LAS __attribute__((address_space(3)))
__device__ __forceinline__ unsigned xb_ld(unsigned* p)              { return __hip_atomic_load(p, __ATOMIC_RELAXED, __HIP_MEMORY_SCOPE_AGENT); }
__device__ __forceinline__ unsigned xb_add(unsigned* p, unsigned v) { return __hip_atomic_fetch_add(p, v, __ATOMIC_RELAXED, __HIP_MEMORY_SCOPE_AGENT); }
__device__ __forceinline__ unsigned xb_xcc_id() { return (unsigned)__builtin_amdgcn_s_getreg((3 << 11) | 20) & 0xFu; }
#define XB_SPIN(cond, bar) do { unsigned _sp = 0; while (cond) { __builtin_amdgcn_s_sleep(1); \
    if ((++_sp & 255u) == 0u) { if (xb_ld(&(bar)[XB_TMO])) break; if (_sp > XB_SPIN_CAP) { atomicAdd(&(bar)[XB_TMO], 1u); break; } } } } while (0)
struct XcdBarrier { unsigned* bar; unsigned x; volatile LAS unsigned* st; };
__device__ __forceinline__ XcdBarrier xcd_barrier_post(unsigned* bar, volatile LAS unsigned* st) {
    XcdBarrier b; b.bar = bar; b.x = xb_xcc_id(); b.st = st;
    if (threadIdx.x == 0) (void)xb_add(&bar[XB_XCNT(b.x)], 1u);
    return b;
}
__device__ __forceinline__ void xcd_barrier_complete(unsigned* bar, unsigned x, unsigned& nloc, unsigned& nx) {
    const unsigned G = gridDim.x * gridDim.y * gridDim.z;
    unsigned sum, cnt, mine, sp = 0u;
    for (;;) {
        sum = 0u; cnt = 0u; mine = 0u;
#pragma unroll
        for (unsigned j = 0; j < 16; ++j) { const unsigned c = xb_ld(&bar[XB_XCNT(j)]); sum += c; cnt += (c > 0u) ? 1u : 0u; mine = (j == x) ? c : mine; }
        if (sum == G) break;
        __builtin_amdgcn_s_sleep(1);
        if ((++sp & 255u) == 0u) { if (xb_ld(&bar[XB_TMO])) break; if (sp > XB_SPIN_CAP) { atomicAdd(&bar[XB_TMO], 1u); break; } }
    }
    nloc = mine > 0u ? mine : 1u; nx = cnt > 0u ? cnt : 1u;
}
__device__ __forceinline__ void xcd_barrier(const XcdBarrier& b) {
    asm volatile("s_waitcnt vmcnt(0)" ::: "memory");
    __syncthreads();
    if (threadIdx.x == 0) {
        unsigned* bar = b.bar;
        __builtin_amdgcn_s_waitcnt(0);
        unsigned nloc = b.st[0], nx = b.st[1];
        if (nloc == 0u) { xcd_barrier_complete(bar, b.x, nloc, nx); b.st[0] = nloc; b.st[1] = nx; }
        const unsigned old = xb_add(&bar[XB_XSUB(b.x)], 1u);
        const unsigned gen = old / nloc;
        if (old + 1u == (gen + 1u) * nloc) {
            __builtin_amdgcn_fence(__ATOMIC_RELEASE, "agent");
            asm volatile("s_waitcnt vmcnt(0)" ::: "memory");
            const unsigned og = xb_add(&bar[XB_TOP], 1u);
            const unsigned tg = og / nx;
            if (og + 1u == (tg + 1u) * nx) xb_add(&bar[XB_TOPGEN], 1u);
            else XB_SPIN(xb_ld(&bar[XB_TOPGEN]) == tg, bar);
            __builtin_amdgcn_fence(__ATOMIC_ACQUIRE, "agent");
            xb_add(&bar[XB_XGEN(b.x)], 1u);
            asm volatile("s_waitcnt vmcnt(0)" ::: "memory");
        } else {
            XB_SPIN(xb_ld(&bar[XB_XGEN(b.x)]) == gen, bar);
            __builtin_amdgcn_fence(__ATOMIC_ACQUIRE, "agent");
            asm volatile("s_waitcnt vmcnt(0)" ::: "memory");
        }
    }
    __syncthreads();
}
typedef XcdBarrier GridBar;
__device__ __forceinline__ void grid_barrier(GridBar& gb) {
    XcdBarrier b = gb;
    asm volatile("" : "+s"(b.x));
    xcd_barrier(b);
}
#endif

struct CvtDesc { const float* src; bf16_t* dst; int K, N, perm; };
__device__ __forceinline__ int up_perm(int n) { const int j = n < EH ? n : n - EH; return (j >> 4) * 32 + (n < EH ? 0 : 16) + (j & 15); }

__device__ __forceinline__ void cvt_load(const CvtDesc& d, int tk, int tn, f32x4 (&r)[4]) {
    const int tid = TID(), c4 = (tid & 15) * 4, n = tn * 64 + c4;
#pragma unroll
    for (int i = 0; i < 4; ++i) { const int k = tk * 128 + (tid >> 4) + 32 * i;
        r[i] = (n < d.N) ? *(const f32x4*)(d.src + (size_t)k * d.N + n) : (f32x4){0.f, 0.f, 0.f, 0.f}; }
}
__device__ __forceinline__ void cvt_store(const CvtDesc& d, int tk, int tn, const f32x4 (&r)[4], char* lds) {
    float* t = (float*)lds;
    const int tid = TID(), c4 = (tid & 15) * 4;
    __syncthreads();
#pragma unroll
    for (int i = 0; i < 4; ++i) { const int kk = (tid >> 4) + 32 * i;
#pragma unroll
        for (int j = 0; j < 4; ++j) t[kk * 65 + c4 + j] = r[i][j]; }
    __syncthreads();
#pragma unroll
    for (int j = 0; j < 2; ++j) {
        const int c = tid + j * NTHREADS, kc = c & 15, nn = c >> 4, n = tn * 64 + nn;
        if (n < d.N) {
            const int nd = d.perm ? up_perm(n) : n;
            u32x4 v;
            v[0] = pack2(t[(kc * 8 + 0) * 65 + nn], t[(kc * 8 + 1) * 65 + nn]);
            v[1] = pack2(t[(kc * 8 + 2) * 65 + nn], t[(kc * 8 + 3) * 65 + nn]);
            v[2] = pack2(t[(kc * 8 + 4) * 65 + nn], t[(kc * 8 + 5) * 65 + nn]);
            v[3] = pack2(t[(kc * 8 + 6) * 65 + nn], t[(kc * 8 + 7) * 65 + nn]);
            *(u32x4*)(d.dst + (size_t)nd * d.K + tk * 128 + kc * 8) = v;
        }
    }
}
__device__ __forceinline__ void cvt_decode(const Params& p, int it, CvtDesc& d, int& tk, int& tn) {
    constexpr int T_IN = (D / 128) * ((PW + 63) / 64), T_OUT = (MIXW / 128) * (D / 64), T_UP = (D / 128) * (2 * EH / 64), T_DN = (EH / 128) * (D / 64);
    constexpr int PER_LAYER = T_IN + T_OUT + NEXP * (T_UP + T_DN);
    const int l = it / PER_LAYER; int r = it % PER_LAYER;
    if (r < T_IN) { d.src = p.w_in + (size_t)l * D * PW; d.dst = (bf16_t*)(p.ws + OFF_WIN) + (size_t)l * 3328 * D; d.K = D; d.N = PW; d.perm = 0; }
    else if ((r -= T_IN) < T_OUT) { d.src = p.w_out + (size_t)l * MIXW * D; d.dst = (bf16_t*)(p.ws + OFF_WOUT) + (size_t)l * D * MIXW; d.K = MIXW; d.N = D; d.perm = 0; }
    else if ((r -= T_OUT) < NEXP * T_UP) { const int e = r / T_UP; r %= T_UP; d.src = p.w_up + ((size_t)l * NEXP + e) * D * 2 * EH; d.dst = (bf16_t*)(p.ws + OFF_WUP) + ((size_t)l * NEXP + e) * 2 * EH * D; d.K = D; d.N = 2 * EH; d.perm = 1; }
    else { r -= NEXP * T_UP; const int e = r / T_DN; r %= T_DN; d.src = p.w_dn + ((size_t)l * NEXP + e) * EH * D; d.dst = (bf16_t*)(p.ws + OFF_WDN) + ((size_t)l * NEXP + e) * D * EH; d.K = EH; d.N = D; d.perm = 0; }
    const int nkt = d.K / 128;
    tk = r % nkt; tn = r / nkt;
}
constexpr int CVT_PER_LAYER = (D / 128) * ((PW + 63) / 64) + (MIXW / 128) * (D / 64) + NEXP * ((D / 128) * (2 * EH / 64) + (EH / 128) * (D / 64));

constexpr int CVT_DENSE0 = (D / 128) * ((PW + 63) / 64) + (MIXW / 128) * (D / 64);
__device__ void phase_prologue(const Params& p, char* lds) {
    const int tid = TID(), bid = BID(), G = GDIM();
    if (bid == 0) {
        float* rope = (float*)(p.ws + OFF_ROPE);
        for (int e = tid; e < 64 * 16; e += NTHREADS) {
            const int pos = e >> 4, i = e & 15;
            const float inv = powf(10000.0f, -(float)i / 16.0f);
            const float ang = (float)pos * inv;
            rope[e * 2] = cosf(ang); rope[e * 2 + 1] = sinf(ang);
        }
    }
    {
        const size_t gt = (size_t)bid * NTHREADS + tid, gs = (size_t)G * NTHREADS;
#define CP_SMALL(NAME, src) for (size_t e = gt; e < N_S_##NAME; e += gs) ((float*)(p.ws + OFF_S_##NAME))[e] = (src)[e]
        CP_SMALL(G1, p.g1); CP_SMALL(G2, p.g2); CP_SMALL(LAM, p.lam); CP_SMALL(GSUB, p.g_sub); CP_SMALL(WDEC, p.w_dec); CP_SMALL(BDEC, p.b_dec); CP_SMALL(GGLA, p.g_gla);
        CP_SMALL(RPB, p.rpb); CP_SMALL(WRG, p.w_rg); CP_SMALL(BRG, p.b_rg); CP_SMALL(WRE, p.w_re); CP_SMALL(BRE, p.b_re); CP_SMALL(GFIN, p.g_fin);
#undef CP_SMALL
        for (size_t e = gt; e < (size_t)DEPTH * 48 * D; e += gs) {
            const int j = (int)(e & 7), lane_ = (int)((e >> 3) & 63), sx = (int)((e >> 9) & 3), c = (int)((e >> 11) % (D / 128)), nb = (int)((e / ((size_t)2048 * (D / 128))) % 3), l = (int)(e / ((size_t)3 * 2048 * (D / 128)));
            const int n = nb * 16 + (lane_ & 15), k = 128 * c + 32 * sx + 8 * (lane_ >> 4) + j;
            const float w = n < 4 ? p.w_rg[((size_t)l * D + k) * 4 + n] : (n < 36 ? p.w_re[((size_t)l * D + k) * 32 + (n - 4)] : 0.f);
            const bf16_t hi = f2bf(w), lo = f2bf(w - bf2f(hi));
            bf16_t* dst = (bf16_t*)(p.ws + OFF_WRT) + (e >> 3) * 16;
            dst[j] = hi; dst[8 + j] = lo;
        }
    }
    {
        int it = bid; CvtDesc dc, dn; int tk = 0, tn = 0, tk2 = 0, tn2 = 0; f32x4 rc[4], rn[4];
        if (it < CVT_DENSE0) { cvt_decode(p, it, dc, tk, tn); cvt_load(dc, tk, tn, rc); }
        while (it < CVT_DENSE0) {
            const int nx = it + G;
            if (nx < CVT_DENSE0) { cvt_decode(p, nx, dn, tk2, tn2); cvt_load(dn, tk2, tn2, rn); }
            cvt_store(dc, tk, tn, rc, lds);
            it = nx; dc = dn; tk = tk2; tn = tn2;
#pragma unroll
            for (int i = 0; i < 4; ++i) rc[i] = rn[i];
        }
    }
    {
        float* cact = (float*)lds;
        float* red = cact + (NB + 1) * D;
        __syncthreads();
        for (int e = tid; e < (NB + 1) * D; e += NTHREADS) { const int r = e / D, k = e % D; const float v = r < NB ? p.c[r * D + k] : p.c_ctx[k]; cact[e] = siluf(v); }
        __syncthreads();
        constexpr int NBLK = 6 * D / 64;
        float* mod = (float*)(p.ws + OFF_MOD);
        for (int it = bid; it < DEPTH * NBLK; it += G) {
            const int l = it / NBLK, n0 = (it % NBLK) * 64, ks = tid >> 6, nn = tid & 63;
            float acc[NB + 1];
#pragma unroll
            for (int r = 0; r <= NB; ++r) acc[r] = 0.f;
            const float* w = p.w_mod + (size_t)l * D * 6 * D + n0 + nn;
            constexpr int MW = (D / 8) % 32 == 0 ? 32 : 8;
            for (int k0 = ks * (D / 8); k0 < (ks + 1) * (D / 8); k0 += MW) {
                float wv[MW];
#pragma unroll
                for (int j = 0; j < MW; ++j) wv[j] = w[(size_t)(k0 + j) * 6 * D];
#pragma unroll
                for (int j = 0; j < MW; ++j)
#pragma unroll
                    for (int r = 0; r <= NB; ++r) acc[r] += cact[r * D + k0 + j] * wv[j];
            }
#pragma unroll
            for (int r = 0; r <= NB; ++r) red[(ks * 64 + nn) * (NB + 1) + r] = acc[r];
            __syncthreads();
            for (int e = tid; e < 64 * (NB + 1); e += NTHREADS) {
                const int r = e / 64, n2 = e % 64; float s = 0.f;
#pragma unroll
                for (int q = 0; q < 8; ++q) s += red[(q * 64 + n2) * (NB + 1) + r];
                mod[((size_t)l * (NB + 1) + r) * 6 * D + n0 + n2] = s + p.b_mod[(size_t)l * 6 * D + n0 + n2];
            }
            __syncthreads();
        }
    }
}

constexpr int CVT_DENSE = (D / 128) * ((PW + 63) / 64) + (MIXW / 128) * (D / 64), CVT_EXPERT = CVT_PER_LAYER - CVT_DENSE;
static_assert(CVT_EXPERT % 8 == 0, "a batch must not straddle the two layers");
__device__ void cvt_ahead(const Params& p, int l, char* lds) {
    int* qi = (int*)(lds - 8);
    int* qc = (int*)(p.ws + OFF_CNT + 2048) + l * 64 + 5;
    constexpr int BATCH = 8, INFL = 8;
    const int total = (l < DEPTH - 1) ? CVT_PER_LAYER : CVT_EXPERT;
    for (;;) {
        __syncthreads();
        if (TID() == 0) *qi = atomicAdd(qc, 1);
        __syncthreads();
        const int b0 = *qi * BATCH;
        if (b0 >= total) break;
        const int n = (b0 + BATCH < total) ? BATCH : total - b0;
        const int it0 = (b0 < CVT_EXPERT) ? l * CVT_PER_LAYER + CVT_DENSE + b0 : (l + 1) * CVT_PER_LAYER + (b0 - CVT_EXPERT);
        CvtDesc ds[INFL]; int tk[INFL], tn[INFL]; f32x4 rr[INFL][4];
#pragma unroll
        for (int k = 0; k < INFL; ++k) if (k < n) { cvt_decode(p, it0 + k, ds[k], tk[k], tn[k]); cvt_load(ds[k], tk[k], tn[k], rr[k]); }
#pragma unroll
        for (int k = 0; k < BATCH; ++k) {
            if (k < n) {
                cvt_store(ds[k % INFL], tk[k % INFL], tn[k % INFL], rr[k % INFL], lds);
                if (k + INFL < n) { cvt_decode(p, it0 + k + INFL, ds[k % INFL], tk[k % INFL], tn[k % INFL]); cvt_load(ds[k % INFL], tk[k % INFL], tn[k % INFL], rr[k % INFL]); }
            }
        }
    }
}

__device__ __forceinline__ void load_pad_start(const PP& p, int layer, int* ps) {
    if (TID() == 0) {
        const int* cnt = (const int*)(p.ws + OFF_CNT) + layer * NEXP; int a = 0;
        for (int e = 0; e < NEXP; ++e) { ps[e] = a; a += (cnt[e] + 255) / 256 * 256; }
        ps[NEXP] = a;
    }
}
__device__ __forceinline__ int tok_batch(int t) { return t < NL ? t / S : NB; }

template <int MODE>
__device__ void phase_norm(const PP& p, int l, char* lds) {
    const int tid = TID(), lane = tid & 63, wave = tid >> 6, G = GDIM();
    int* ps = (int*)lds;
    float* X = (float*)(p.ws + OFF_X);
    bf16_t* H = (bf16_t*)(p.ws + OFF_H);
    const bf16_t* Y = (const bf16_t*)(p.ws + OFF_Y);
    const int* route = (const int*)(p.ws + OFF_ROUTE);
    const float* mod = (const float*)(p.ws + OFF_MOD);
    __syncthreads();
    const bool combine = (MODE == 0 && l > 0) || MODE == 2;
    const int lprev = MODE == 2 ? DEPTH - 1 : l - 1;
    if (combine) load_pad_start(p, lprev, ps);
    __syncthreads();
    const int ntok = (MODE == 2) ? NL : NT, stride = G * 8;
    constexpr int NV = D / 256;
    int t = BID() * 8 + wave;
    f32x4 xn[NV]; u32x4 rn0 = {0u, 0u, 0u, 0u}; u32x2 rn1 = {0u, 0u};
    const bool from_input = (MODE == 0) ? (l <= 1) : (DEPTH == 1);
    const bf16_t* XDb = (const bf16_t*)(p.ws + OFF_XD);
    u32x2 dn[NV];
#define NORM_XROW(t_) (from_input ? ((t_) < NL ? p.x + (size_t)(t_) * D : p.ctx + (size_t)((t_) - NL) * D) : X + (size_t)(t_) * D)
    if (t < ntok) {
        const float* xr = NORM_XROW(t);
#pragma unroll
        for (int i = 0; i < NV; ++i) xn[i] = *(const f32x4*)(xr + i * 256 + lane * 4);
        if (combine) { rn0 = *(const u32x4*)(route + (size_t)t * 8); rn1 = *(const u32x2*)(route + (size_t)t * 8 + 4);
#pragma unroll
            for (int i = 0; i < NV; ++i) dn[i] = *(const u32x2*)(XDb + (size_t)t * D + i * 256 + lane * 4); }
    }
    while (t < ntok) {
        const int mr = tok_batch(t), tn = t + stride;
        f32x4 xv[NV];
#pragma unroll
        for (int i = 0; i < NV; ++i) xv[i] = xn[i];
        if (combine) {
#pragma unroll
            for (int i = 0; i < NV; ++i) { xv[i][0] += u2f(dn[i][0] << 16); xv[i][1] += u2f(dn[i][0] & 0xffff0000u); xv[i][2] += u2f(dn[i][1] << 16); xv[i][3] += u2f(dn[i][1] & 0xffff0000u); }
        }
        u32x2 ya[NV], yb[NV]; f32x4 m5v[NV]; float g0 = 0.f, g1 = 0.f;
        if (combine) {
            const int e0 = (int)rn0[0], e1 = (int)rn0[1], s0 = (int)rn0[2], s1 = (int)rn0[3];
            g0 = u2f(rn1[0]); g1 = u2f(rn1[1]);
            const bf16_t* y0 = Y + (size_t)(ps[e0] + s0) * D; const bf16_t* y1 = Y + (size_t)(ps[e1] + s1) * D;
            const float* m5 = mod + ((size_t)lprev * (NB + 1) + mr) * 6 * D + 5 * D;
#pragma unroll
            for (int i = 0; i < NV; ++i) { ya[i] = *(const u32x2*)(y0 + i * 256 + lane * 4); yb[i] = *(const u32x2*)(y1 + i * 256 + lane * 4); m5v[i] = *(const f32x4*)(m5 + i * 256 + lane * 4); }
        }
        f32x4 gv[NV], shv[NV], scv[NV];
        if (MODE == 0) {
            const float* gg = p.sm(OFF_S_G1) + (size_t)l * D; const float* mrow = mod + ((size_t)l * (NB + 1) + mr) * 6 * D;
#pragma unroll
            for (int i = 0; i < NV; ++i) { gv[i] = *(const f32x4*)(gg + i * 256 + lane * 4); shv[i] = *(const f32x4*)(mrow + i * 256 + lane * 4); scv[i] = *(const f32x4*)(mrow + D + i * 256 + lane * 4); }
        } else {
#pragma unroll
            for (int i = 0; i < NV; ++i) gv[i] = *(const f32x4*)(p.sm(OFF_S_GFIN) + i * 256 + lane * 4);
        }
        if (tn < ntok) {
            const float* xr = NORM_XROW(tn);
#pragma unroll
            for (int i = 0; i < NV; ++i) xn[i] = *(const f32x4*)(xr + i * 256 + lane * 4);
            if (combine) { rn0 = *(const u32x4*)(route + (size_t)tn * 8); rn1 = *(const u32x2*)(route + (size_t)tn * 8 + 4);
#pragma unroll
                for (int i = 0; i < NV; ++i) dn[i] = *(const u32x2*)(XDb + (size_t)tn * D + i * 256 + lane * 4); }
        }
        if (combine) {
#pragma unroll
            for (int i = 0; i < NV; ++i) {
                xv[i][0] += m5v[i][0] * (g0 * u2f(ya[i][0] << 16) + g1 * u2f(yb[i][0] << 16));
                xv[i][1] += m5v[i][1] * (g0 * u2f(ya[i][0] & 0xffff0000u) + g1 * u2f(yb[i][0] & 0xffff0000u));
                xv[i][2] += m5v[i][2] * (g0 * u2f(ya[i][1] << 16) + g1 * u2f(yb[i][1] << 16));
                xv[i][3] += m5v[i][3] * (g0 * u2f(ya[i][1] & 0xffff0000u) + g1 * u2f(yb[i][1] & 0xffff0000u));
            }
        }
        if (MODE == 0 && l > 0) {
#pragma unroll
            for (int i = 0; i < NV; ++i) *(f32x4*)(X + (size_t)t * D + i * 256 + lane * 4) = xv[i];
        }
        float ss = 0.f;
#pragma unroll
        for (int i = 0; i < NV; ++i) ss += xv[i][0] * xv[i][0] + xv[i][1] * xv[i][1] + xv[i][2] * xv[i][2] + xv[i][3] * xv[i][3];
        ss = wave_sum(ss);
        const float rstd = 1.0f / sqrtf(ss / (float)D + NORM_EPS);
        if (MODE == 2) {
#pragma unroll
            for (int i = 0; i < NV; ++i) { f32x4 v = {xv[i][0] * rstd * gv[i][0], xv[i][1] * rstd * gv[i][1], xv[i][2] * rstd * gv[i][2], xv[i][3] * rstd * gv[i][3]};
                *(f32x4*)(p.out + (size_t)t * D + i * 256 + lane * 4) = v; }
        } else {
#pragma unroll
            for (int i = 0; i < NV; ++i) {
                float hv[4];
#pragma unroll
                for (int j = 0; j < 4; ++j) hv[j] = xv[i][j] * rstd * gv[i][j] * (1.0f + scv[i][j]) + shv[i][j];
                u32x2 o; o[0] = pack2(hv[0], hv[1]); o[1] = pack2(hv[2], hv[3]);
                *(u32x2*)(H + (size_t)t * D + i * 256 + lane * 4) = o;
            }
        }
        t = tn;
    }
#undef NORM_XROW
}

constexpr int RXT = (NC * 16) / NL, RRT = 16 + RXT;
static_assert((NC * 16) % NL == 0 && RXT >= 1 && RXT <= 8, "context tokens must split evenly over the latent groups");
static_assert(D / 128 == 8, "one 128-column chunk per wave");
constexpr int RL_XS = 0, RL_VEC = RL_XS + RRT * D * 4, RL_RSV = RL_VEC + 4 * D * 4, RL_PLG = RL_RSV + 128 + RXT * 32, RL_LGS = RL_PLG + 8 * RRT * 48 * 4,
              RL_REC = RL_LGS + (RRT * 49 * 4 + 127) / 128 * 128, RL_HIST = RL_REC + 2048 * 16, RL_BIAS = RL_HIST + 256, ROUTER_LDS = RL_BIAS + 256;
__device__ void phase_router(const PP& p, int l, char* lds) {
    const int tid = TID(), lane = tid & 63, wave = tid >> 6, G = GDIM(), tt = lane & 15, q = lane >> 4;
    float* xs = (float*)(lds + RL_XS);
    float* gam = (float*)(lds + RL_VEC); float* shl = gam + D; float* gamx = shl + D; float* shx = gamx + D;
    float* rsv = (float*)(lds + RL_RSV);
    float* rsp = (float*)(lds + RL_RSV + 128);
    float* plg = (float*)(lds + RL_PLG);
    float* lgs = (float*)(lds + RL_LGS);
    int* recs = (int*)(lds + RL_REC);
    int* hist = (int*)(lds + RL_HIST); int* base = hist + NEXP;
    float* rbias = (float*)(lds + RL_BIAS);
    float* X = (float*)(p.ws + OFF_X);
    bf16_t* H = (bf16_t*)(p.ws + OFF_H);
    const bf16_t* XDb = (const bf16_t*)(p.ws + OFF_XD);
    const float* mod = (const float*)(p.ws + OFF_MOD);
    const float* gg = p.sm(OFF_S_G2) + (size_t)l * D;
    const int xt = (l == DEPTH - 1) ? 0 : RXT;
    const int ngr = NL / 16, nrows = 16 + xt;
    const int ngb = (ngr + G - 1) / G;
    constexpr int NV = D / 256;
    __syncthreads();
    bf16x8 wr[4][3][2];
    {
        const bf16_t* wp = (const bf16_t*)((const float*)(p.ws + OFF_WRT) + (size_t)l * 48 * D) + ((size_t)wave * 4) * 1024 + lane * 16;
#pragma unroll
        for (int ks = 0; ks < 4; ++ks)
#pragma unroll
            for (int nb = 0; nb < 3; ++nb) { const bf16_t* w_ = wp + (size_t)nb * (D / 128) * 4096 + ks * 1024; wr[ks][nb][0] = *(const bf16x8*)w_; wr[ks][nb][1] = *(const bf16x8*)(w_ + 8); }
    }
    if (tid < 36) rbias[tid] = tid < 4 ? p.sm(OFF_S_BRG)[l * 4 + tid] : p.sm(OFF_S_BRE)[l * 32 + tid - 4];
    if (xt > 0) {
        const float* mrowx = mod + ((size_t)l * (NB + 1) + NB) * 6 * D;
        for (int k = tid; k < D; k += NTHREADS) { gamx[k] = gg[k] * (1.0f + mrowx[4 * D + k]); shx[k] = mrowx[3 * D + k]; }
    }
#define R_TOK(g_, r_) ((r_) < 16 ? (g_) * 16 + (r_) : NL + (g_) * RXT + ((r_) - 16))
#define R_SRC(g_, r_) ((l == 0) ? ((r_) < 16 ? p.x + (size_t)((g_) * 16 + (r_)) * D : p.ctx + (size_t)((g_) * RXT + ((r_) - 16)) * D) : X + (size_t)R_TOK(g_, r_) * D)
    static_assert(D == 2 * NTHREADS || D < 2 * NTHREADS, "extra rows: two columns per thread");
    f32x4 pv[2][NV]; u32x2 pd[2][NV]; float pxa[RXT], pxb[RXT]; unsigned pxd[RXT]; float psc[D / NTHREADS], psh[D / NTHREADS];
    static_assert(D % NTHREADS == 0, "modulation vectors: D / 512 columns per thread");
#define R_FETCH(g_) do { _Pragma("unroll") for (int i = 0; i < 2; ++i) { const int r_ = wave + 8 * i; const float* xs_ = R_SRC(g_, r_); const bf16_t* dr_ = XDb + (size_t)R_TOK(g_, r_) * D; \
        _Pragma("unroll") for (int j = 0; j < NV; ++j) { pv[i][j] = *(const f32x4*)(xs_ + j * 256 + lane * 4); pd[i][j] = *(const u32x2*)(dr_ + j * 256 + lane * 4); } } \
        if (xt > 0 && 2 * tid < D) { _Pragma("unroll") for (int e_ = 0; e_ < RXT; ++e_) { const float* xs_ = R_SRC(g_, 16 + e_); pxa[e_] = xs_[2 * tid]; pxb[e_] = xs_[2 * tid + 1]; \
            pxd[e_] = *(const unsigned*)(XDb + (size_t)R_TOK(g_, 16 + e_) * D + 2 * tid); } } \
        { const float* mr_ = mod + ((size_t)l * (NB + 1) + tok_batch((g_) * 16)) * 6 * D; _Pragma("unroll") for (int j = 0; j < D / NTHREADS; ++j) { psc[j] = mr_[4 * D + tid + j * NTHREADS]; psh[j] = mr_[3 * D + tid + j * NTHREADS]; } } } while (0)
    float ggk[D / NTHREADS];
#pragma unroll
    for (int j = 0; j < D / NTHREADS; ++j) ggk[j] = gg[tid + j * NTHREADS];
    int g = BID();
    if (g < ngr) R_FETCH(g);
    int gi = 0;
    for (; g < ngr; g += G, ++gi) {
        const int tid = TID(), lane = tid & 63, wave = tid >> 6, tt = lane & 15, q = lane >> 4;
        const int t0 = g * 16;
#pragma unroll
        for (int i = 0; i < 2; ++i) {
            const int r = wave + 8 * i;
            {
                float ss = 0.f;
#pragma unroll
                for (int j = 0; j < NV; ++j) {
                    f32x4 v = pv[i][j]; const u32x2 dv = pd[i][j];
                    v[0] += u2f(dv[0] << 16); v[1] += u2f(dv[0] & 0xffff0000u); v[2] += u2f(dv[1] << 16); v[3] += u2f(dv[1] & 0xffff0000u);
                    *(f32x4*)(xs + r * D + j * 256 + lane * 4) = v;
                    ss += v[0] * v[0] + v[1] * v[1] + v[2] * v[2] + v[3] * v[3];
                }
                ss = wave_sum(ss);
                if (lane == 0) rsv[r] = 1.0f / sqrtf(ss / (float)D + NORM_EPS);
            }
        }
        if (xt > 0) {
#pragma unroll
            for (int e = 0; e < RXT; ++e) {
                float ss = 0.f;
                if (2 * tid < D) {
                    const float a = pxa[e] + u2f(pxd[e] << 16), b2 = pxb[e] + u2f(pxd[e] & 0xffff0000u);
                    xs[(16 + e) * D + 2 * tid] = a; xs[(16 + e) * D + 2 * tid + 1] = b2;
                    ss = a * a + b2 * b2;
                }
                ss = wave_sum(ss);
                if (lane == 0) rsp[e * 8 + wave] = ss;
            }
        }
#pragma unroll
        for (int j = 0; j < D / NTHREADS; ++j) { const int k = tid + j * NTHREADS; gam[k] = ggk[j] * (1.0f + psc[j]); shl[k] = psh[j]; }
        __syncthreads();
        if (g + G < ngr) R_FETCH(g + G);
#define R_H2(xrow_, gm_, sh_, rs_, hi_, lo_) do { const f32x4 x0 = *(const f32x4*)((xrow_) + k0), x1 = *(const f32x4*)((xrow_) + k0 + 4); \
                const f32x4 g0 = *(const f32x4*)((gm_) + k0), g1 = *(const f32x4*)((gm_) + k0 + 4), s0 = *(const f32x4*)((sh_) + k0), s1 = *(const f32x4*)((sh_) + k0 + 4); \
                float hv[8]; _Pragma("unroll") for (int e = 0; e < 4; ++e) { hv[e] = x0[e] * (rs_) * g0[e] + s0[e]; hv[4 + e] = x1[e] * (rs_) * g1[e] + s1[e]; } \
                u32x4 h_, l_; _Pragma("unroll") for (int e = 0; e < 4; ++e) { h_[e] = pack2(hv[2 * e], hv[2 * e + 1]); l_[e] = pack2(hv[2 * e] - u2f(h_[e] << 16), hv[2 * e + 1] - u2f(h_[e] & 0xffff0000u)); } \
                hi_ = h_; lo_ = l_; } while (0)
        {
            f32x4 acc[3];
#pragma unroll
            for (int nb = 0; nb < 3; ++nb) acc[nb] = (f32x4){0.f, 0.f, 0.f, 0.f};
            const float rs = rsv[tt];
#pragma unroll
            for (int ks = 0; ks < 4; ++ks) {
                const int k0 = 128 * wave + 32 * ks + 8 * q;
                u32x4 hi, lo;
                R_H2(xs + tt * D, gam, shl, rs, hi, lo);
                *(u32x4*)(H + (size_t)(t0 + tt) * D + k0) = hi;
                const bf16x8 ah = __builtin_bit_cast(bf16x8, hi), al = __builtin_bit_cast(bf16x8, lo);
#pragma unroll
                for (int nb = 0; nb < 3; ++nb) { acc[nb] = MFMA16(ah, wr[ks][nb][0], acc[nb]); acc[nb] = MFMA16(ah, wr[ks][nb][1], acc[nb]); acc[nb] = MFMA16(al, wr[ks][nb][0], acc[nb]); }
            }
#pragma unroll
            for (int nb = 0; nb < 3; ++nb)
#pragma unroll
                for (int r = 0; r < 4; ++r) plg[(wave * RRT + 4 * q + r) * 48 + nb * 16 + tt] = acc[nb][r];
        }
        if (xt > 0) {
            f32x4 acc[3];
#pragma unroll
            for (int nb = 0; nb < 3; ++nb) acc[nb] = (f32x4){0.f, 0.f, 0.f, 0.f};
            const int rx = 16 + (tt < RXT ? tt : 0);
            float sq = 0.f;
#pragma unroll
            for (int w = 0; w < 8; ++w) sq += rsp[(rx - 16) * 8 + w];
            const float rsx = 1.0f / sqrtf(sq / (float)D + NORM_EPS);
#pragma unroll
            for (int ks = 0; ks < 4; ++ks) {
                const int k0 = 128 * wave + 32 * ks + 8 * q;
                u32x4 hx, lx;
                R_H2(xs + rx * D, gamx, shx, rsx, hx, lx);
                if (tt < RXT) *(u32x4*)(H + (size_t)(NL + g * RXT + tt) * D + k0) = hx;
                const bf16x8 bh = __builtin_bit_cast(bf16x8, hx), bl = __builtin_bit_cast(bf16x8, lx);
#pragma unroll
                for (int nb = 0; nb < 3; ++nb) { acc[nb] = MFMA16(bh, wr[ks][nb][0], acc[nb]); acc[nb] = MFMA16(bh, wr[ks][nb][1], acc[nb]); acc[nb] = MFMA16(bl, wr[ks][nb][0], acc[nb]); }
            }
#pragma unroll
            for (int nb = 0; nb < 3; ++nb)
#pragma unroll
                for (int r = 0; r < 4; ++r) if (4 * q + r < RXT) plg[(wave * RRT + 16 + 4 * q + r) * 48 + nb * 16 + tt] = acc[nb][r];
        }
#undef R_H2
        __syncthreads();
        for (int e = tid; e < RRT * 48; e += NTHREADS) {
            float sacc = 0.f;
#pragma unroll
            for (int w = 0; w < 8; ++w) sacc += plg[w * RRT * 48 + e];
            lgs[(e / 48) * 49 + (e % 48)] = sacc;
        }
        __syncthreads();
        if (wave == 0 && lane < nrows) {
            const int tk = R_TOK(g, lane);
            float lg[4];
            int grp = 0; float gmax = -INFINITY;
#pragma unroll
            for (int o = 0; o < 4; ++o) { lg[o] = lgs[lane * 49 + o] + rbias[o]; if (lg[o] > gmax) { gmax = lg[o]; grp = o; } }
            float gs = 0.f;
#pragma unroll
            for (int o = 0; o < 4; ++o) gs += expf(lg[o] - gmax);
            const float pg = 1.0f / gs;
            float v0 = -INFINITY, v1 = -INFINITY; int i0 = 0, i1 = 0;
#pragma unroll
            for (int o = 0; o < 8; ++o) { const float v = lgs[lane * 49 + 4 + grp * 8 + o] + rbias[4 + grp * 8 + o];
                if (v > v0) { v1 = v0; i1 = i0; v0 = v; i0 = o; } else if (v > v1) { v1 = v; i1 = o; } }
            const float e1v = expf(v1 - v0), den = 1.0f / (1.0f + e1v);
            int* rec = recs + (gi * RRT + lane) * 4;
            rec[0] = tk; rec[1] = (grp * 8 + i0) | ((grp * 8 + i1) << 8); rec[2] = (int)f2u(den * pg); rec[3] = (int)f2u(e1v * den * pg);
        }
    }
#undef R_FETCH
#undef R_SRC
#undef R_TOK
    __syncthreads();
    if (tid < NEXP) hist[tid] = 0;
    __syncthreads();
    const int nrec = ngb * RRT;
    int myslot[4][2];
#define R_VALID(ri_) ({ const int gi_ = (ri_) / RRT, ln_ = (ri_) % RRT; (BID() + gi_ * G) < ngr && ln_ < nrows; })
#pragma unroll
    for (int k = 0; k < 4; ++k) {
        const int ri = tid + k * NTHREADS; myslot[k][0] = myslot[k][1] = 0;
        if (ri < nrec) { const int* rec = recs + ri * 4;
            if (R_VALID(ri)) { const int ee = rec[1]; myslot[k][0] = atomicAdd(&hist[ee & 255], 1); myslot[k][1] = atomicAdd(&hist[ee >> 8], 1); } }
    }
    __syncthreads();
    if (tid < NEXP) { const int c = hist[tid]; base[tid] = c ? atomicAdd((int*)(p.ws + OFF_CNT) + l * NEXP + tid, c) : 0; }
    __syncthreads();
#pragma unroll
    for (int k = 0; k < 4; ++k) {
        const int ri = tid + k * NTHREADS;
        if (ri < nrec) { const int* rec = recs + ri * 4;
            if (R_VALID(ri)) {
                const int tk = rec[0], e0 = rec[1] & 255, e1 = rec[1] >> 8, s0 = base[e0] + myslot[k][0], s1 = base[e1] + myslot[k][1];
                int* list = (int*)(p.ws + OFF_LIST);
                list[(size_t)e0 * NT + s0] = tk; list[(size_t)e1 * NT + s1] = tk;
                int* rt = (int*)(p.ws + OFF_ROUTE) + (size_t)tk * 8;
                rt[0] = e0; rt[1] = e1; rt[2] = s0; rt[3] = s1; rt[4] = rec[2]; rt[5] = rec[3];
            } }
    }
#undef R_VALID
}

#ifdef EMU
#define LAS3
__device__ __forceinline__ void emu_glds16(const void* g, void* l) { memcpy((char*)l + (threadIdx.x & 63) * 16, g, 16); }
#define GLDS16(gptr, ldsptr) emu_glds16((gptr), (ldsptr))
#define GLDS16_ASM(gptr, ldsptr) emu_glds16((gptr), (ldsptr))
#define WAIT_V(n) do {} while (0)
#define WAIT_L(n) do {} while (0)
#define S_BAR() __syncthreads()
#define SCHED_BAR() do {} while (0)
#define SETPRIO(x) do {} while (0)
#define READFIRSTLANE(x) (x)
#else
#define LAS3 __attribute__((address_space(3)))
#define GLDS16(gptr, ldsptr) __builtin_amdgcn_global_load_lds((const unsigned*)(gptr), (LAS3 unsigned*)(ldsptr), 16, 0, 0)
#define WAIT_V(n) asm volatile("s_waitcnt vmcnt(" #n ")" ::: "memory")
__device__ __forceinline__ void glds16_asm(const void* gsrc, unsigned lds_dst) {
    unsigned keep;
    asm volatile("s_mov_b32 %0, m0\n\ts_mov_b32 m0, %2\n\ts_nop 0\n\tglobal_load_lds_dwordx4 %1, off\n\ts_mov_b32 m0, %0" : "=&s"(keep) : "v"(gsrc), "s"(lds_dst) : "memory");
}
#define GLDS16_ASM(gptr, ldsptr) glds16_asm((gptr), (unsigned)(uintptr_t)(ldsptr))
#define WAIT_L(n) asm volatile("s_waitcnt lgkmcnt(" #n ")" ::: "memory")
#define S_BAR() __builtin_amdgcn_s_barrier()
#define SCHED_BAR() __builtin_amdgcn_sched_barrier(0)
#define SETPRIO(x) __builtin_amdgcn_s_setprio(x)
#define READFIRSTLANE(x) __builtin_amdgcn_readfirstlane(x)
#endif
namespace g8 {
constexpr int BM = 256, BK = 64, HALF = 128, HTB = HALF * BK * 2, STAGE_BYTES = 8 * HTB;
__device__ __forceinline__ int lds_byte(int r, int c) { const int st = (r >> 4) * 2 + (c >> 5), rr = r & 15, cc = c & 31, ob = rr * 64 + cc * 2; return st * 1024 + (ob ^ (((ob >> 9) & 1) << 5)); }
__device__ __forceinline__ void stage_rc(int b, int& R, int& C) { const int st = b / 1024, sb = b % 1024, swz = sb ^ (((sb >> 9) & 1) << 5); R = (st >> 1) * 16 + swz / 64; C = (st & 1) * 32 + (swz % 64) / 2; }
struct Unit { int pm, pn; const bf16_t* bt; int e; };
typedef f32x4 Acc[2][2][4][2];

template <class Sched, class Epi>
__device__ __forceinline__ void gemm_phase(char* lds_generic, const bf16_t* A, const int K, const Sched& S, const Epi& E) {
    LAS3 unsigned char* lds = (LAS3 unsigned char*)lds_generic;
    const int tid = TID(), wid = READFIRSTLANE(tid >> 6), lane = tid & 63, wr = wid >> 2, wc = wid & 3, fr = lane & 15, fq = lane >> 4;
    const int nt = K / BK;
    int sR[2], sC[2]; unsigned voffB[2];
#pragma unroll
    for (int i = 0; i < 2; ++i) { stage_rc(tid * 16 + i * 8192, sR[i], sC[i]); voffB[i] = (unsigned)(sR[i] * K + sC[i]) * 2u; }
    const size_t kstep = (size_t)(BK * 2);
    const size_t hstep = (size_t)HALF * K * 2;
    const unsigned ldsw = (unsigned)wid * 1024u;
    const int aoff = lds_byte(wr * 64 + fr, fq * 8), boff = lds_byte(wc * 32 + fr, fq * 8);
#define G8_SA(b, h) (((b) * 2 + (h)) * HTB)
#define G8_SB(b, h) ((4 + (b) * 2 + (h)) * HTB)
#define G8_STAGE(bufoff, gbase, voff) do { _Pragma("unroll") for (int _i = 0; _i < 2; ++_i) GLDS16((const char*)(gbase) + (voff)[_i], lds + (bufoff) + ldsw + _i * 8192); } while (0)
#define G8_LDA(dst, b, h) do { _Pragma("unroll") for (int m = 0; m < 4; ++m) _Pragma("unroll") for (int k = 0; k < 2; ++k) dst[m][k] = *(const LAS3 bf16x8*)(lds + G8_SA(b, h) + aoff + m * 2048 + k * 1024); } while (0)
#define G8_LDB(dst, b, h) do { _Pragma("unroll") for (int n = 0; n < 2; ++n) _Pragma("unroll") for (int k = 0; k < 2; ++k) dst[n][k] = *(const LAS3 bf16x8*)(lds + G8_SB(b, h) + boff + n * 2048 + k * 1024); } while (0)
#define G8_MMA(ai, bj, At, Bt) do { SETPRIO(1); _Pragma("unroll") for (int m = 0; m < 4; ++m) _Pragma("unroll") for (int n = 0; n < 2; ++n) _Pragma("unroll") for (int k = 0; k < 2; ++k) \
        acc[ai][bj][m][n] = MFMA16(Bt[n][k], At[m][k], acc[ai][bj][m][n]); SETPRIO(0); } while (0)
#define G8_VOFFA(dst, u) do { _Pragma("unroll") for (int _h = 0; _h < 2; ++_h) _Pragma("unroll") for (int _i = 0; _i < 2; ++_i) dst[_h][_i] = (unsigned)(S.arow(u, _h * HALF + sR[_i]) * K + sC[_i]) * 2u; } while (0)
    Unit cur, nxt; int ui = 0;
    if (!S.next(0, cur)) return;
    Acc acc;
#pragma unroll
    for (int a = 0; a < 2; ++a)
#pragma unroll
        for (int b = 0; b < 2; ++b)
#pragma unroll
            for (int m = 0; m < 4; ++m)
#pragma unroll
                for (int n = 0; n < 2; ++n) acc[a][b][m][n] = (f32x4){0.f, 0.f, 0.f, 0.f};
    bf16x8 At[4][2], B0[2][2], B1[2][2];
    unsigned cvA[2][2], nvA[2][2];
    G8_VOFFA(cvA, cur);
    const char* cA = (const char*)A; const char* cB = (const char*)cur.bt;
    G8_STAGE(G8_SB(0, 0), cB, voffB); G8_STAGE(G8_SA(0, 0), cA, cvA[0]); G8_STAGE(G8_SB(0, 1), cB + hstep, voffB); G8_STAGE(G8_SA(0, 1), cA, cvA[1]);
    if (wr == 1) S_BAR();
    WAIT_V(4); S_BAR();
    G8_STAGE(G8_SB(1, 0), cB + kstep, voffB); G8_STAGE(G8_SA(1, 0), cA + kstep, cvA[0]); G8_STAGE(G8_SB(1, 1), cB + hstep + kstep, voffB);
    WAIT_V(6); S_BAR();
    for (;;) {
        const bool has_next = S.next(ui + 1, nxt);
        if (has_next) { G8_VOFFA(nvA, nxt); } else {
#pragma unroll
            for (int h = 0; h < 2; ++h)
#pragma unroll
                for (int i = 0; i < 2; ++i) nvA[h][i] = cvA[h][i]; }
        const char* nB = has_next ? (const char*)nxt.bt : cB;
        for (int t = 0; t < nt; t += 2) {
            const bool last = (t == nt - 2);
            const char* a1 = cA + (size_t)(t + 1) * kstep;
            const char* a2 = last ? cA : cA + (size_t)(t + 2) * kstep; const char* b2 = last ? nB : cB + (size_t)(t + 2) * kstep;
            const char* a3 = a2 + kstep; const char* b3 = b2 + kstep;
            unsigned v2[2][2];
#pragma unroll
            for (int h = 0; h < 2; ++h)
#pragma unroll
                for (int i = 0; i < 2; ++i) v2[h][i] = last ? nvA[h][i] : cvA[h][i];
            G8_LDB(B0, 0, 0); SCHED_BAR(); G8_LDA(At, 0, 0); G8_STAGE(G8_SA(1, 1), a1, cvA[1]);
            WAIT_L(8); S_BAR(); WAIT_L(0); G8_MMA(0, 0, At, B0); S_BAR(); SCHED_BAR();
            G8_LDB(B1, 0, 1); G8_STAGE(G8_SB(0, 0), b2, voffB);
            S_BAR(); WAIT_L(0); G8_MMA(0, 1, At, B1); S_BAR();
            G8_LDA(At, 0, 1); G8_STAGE(G8_SA(0, 0), a2, v2[0]);
            S_BAR(); WAIT_L(0); G8_MMA(1, 0, At, B0); S_BAR(); SCHED_BAR();
            G8_STAGE(G8_SB(0, 1), b2 + hstep, voffB);
            WAIT_V(6); S_BAR(); G8_MMA(1, 1, At, B1); S_BAR();
            G8_LDB(B0, 1, 0); SCHED_BAR(); G8_LDA(At, 1, 0); G8_STAGE(G8_SA(0, 1), a2, v2[1]);
            WAIT_L(8); S_BAR(); WAIT_L(0); G8_MMA(0, 0, At, B0); S_BAR(); SCHED_BAR();
            G8_LDB(B1, 1, 1); G8_STAGE(G8_SB(1, 0), b3, voffB);
            S_BAR(); WAIT_L(0); G8_MMA(0, 1, At, B1); S_BAR();
            G8_LDA(At, 1, 1); G8_STAGE(G8_SA(1, 0), a3, v2[0]);
            S_BAR(); WAIT_L(0); G8_MMA(1, 0, At, B0); S_BAR(); SCHED_BAR();
            G8_STAGE(G8_SB(1, 1), b3 + hstep, voffB);
            WAIT_V(6); S_BAR(); G8_MMA(1, 1, At, B1); S_BAR();
        }
        E(acc, cur, wr, wc, fr, fq);
        if (!has_next) break;
#pragma unroll
        for (int a = 0; a < 2; ++a)
#pragma unroll
            for (int b = 0; b < 2; ++b)
#pragma unroll
                for (int m = 0; m < 4; ++m)
#pragma unroll
                    for (int n = 0; n < 2; ++n) acc[a][b][m][n] = (f32x4){0.f, 0.f, 0.f, 0.f};
        cur = nxt; cB = nB; ++ui;
#pragma unroll
        for (int h = 0; h < 2; ++h)
#pragma unroll
            for (int i = 0; i < 2; ++i) cvA[h][i] = nvA[h][i];
    }
    WAIT_V(0);
    if (wr == 0) S_BAR();
    S_BAR();
#undef G8_SA
#undef G8_SB
#undef G8_STAGE
#undef G8_LDA
#undef G8_LDB
#undef G8_MMA
#undef G8_VOFFA
}

struct DenseOrder {
    int nM, nN, nwg, G, c; const bf16_t* Bt; int K;
    __device__ __forceinline__ void init(int M, int N, int K_, const bf16_t* Bt_, int G_, int c_) { nM = M / BM; nN = N / BM; nwg = nM * nN; G = G_; c = c_; Bt = Bt_; K = K_; }
    __device__ __forceinline__ bool next(int i, Unit& u) const {
        const long L = (long)i * G + c; if (L >= nwg) return false;
        int wgid = (int)L; { const int q = nwg / 8, r = nwg % 8, xcd = wgid % 8, off = wgid / 8; wgid = (xcd < r ? xcd * (q + 1) : r * (q + 1) + (xcd - r) * q) + off; }
        const int nig = 8 * nN, gid = wgid / nig, fm = gid * 8, gsz = (nM - fm) < 8 ? (nM - fm) : 8;
        u.pm = fm + ((wgid % nig) % gsz); u.pn = (wgid % nig) / gsz; u.bt = Bt + (size_t)u.pn * BM * K; u.e = 0; return true;
    }
    __device__ __forceinline__ int arow(const Unit& u, int r) const { return u.pm * BM + r; }
};
}

constexpr int PWP = 3328;
struct EpiIn {
    bf16_t* P; const float* rope;
    __device__ __forceinline__ void operator()(const g8::Acc& acc, const g8::Unit& u, int wr, int wc, int fr, int fq) const {
#pragma unroll
        for (int ai = 0; ai < 2; ++ai)
#pragma unroll
            for (int m = 0; m < 4; ++m) {
                const int row = u.pm * 256 + ai * 128 + wr * 64 + m * 16 + fr;
                const int s = row % S, prow = s >> 6, pcol = s & 63;
#pragma unroll
                for (int bj = 0; bj < 2; ++bj) {
                    const int c0 = u.pn * 256 + bj * 128 + wc * 32 + 4 * fq;
                    f32x4 v0 = acc[ai][bj][m][0], v1 = acc[ai][bj][m][1];
                    if (c0 < C_VA && row < NL) {
                        const int pos = (c0 & 32) ? pcol : prow;
#pragma unroll
                        for (int j = 0; j < 4; ++j) {
                            const float cs = rope[(pos * 16 + 4 * fq + j) * 2], sn = rope[(pos * 16 + 4 * fq + j) * 2 + 1];
                            const float a = v0[j], b = v1[j];
                            v0[j] = a * cs - b * sn; v1[j] = b * cs + a * sn;
                        }
                    }
#pragma unroll
                    for (int n = 0; n < 2; ++n) {
                        const int c = c0 + 16 * n;
                        float sc = 1.0f;
                        if (c < C_KA) sc = 0.125f * LOG2E;
                        else if (c >= C_QB && c < C_KB) sc = 0.17677669529663687f;
                        else if (c >= C_QN && c < C_KN) sc = 0.125f * LOG2E;
                        const f32x4 v = n ? v1 : v0;
                        if (c < PW) { u32x2 o; o[0] = pack2(v[0] * sc, v[1] * sc); o[1] = pack2(v[2] * sc, v[3] * sc); *(u32x2*)(P + (size_t)row * PW + c) = o; }
                    }
                }
            }
    }
};
__device__ void phase_gemm_in(const PP& p, int l, char* lds) {
    g8::DenseOrder S; S.init(NT, PWP, D, (const bf16_t*)(p.ws + OFF_WIN) + (size_t)l * PWP * D, GDIM(), BID());
    float* rope_l = (float*)(lds + g8::STAGE_BYTES + 1024);
    __syncthreads();
    for (int e = TID(); e < 64 * 16 * 2; e += NTHREADS) rope_l[e] = ((const float*)(p.ws + OFF_ROPE))[e];
    __syncthreads();
    EpiIn epi{(bf16_t*)(p.ws + OFF_P), rope_l};
    g8::gemm_phase(lds, (const bf16_t*)(p.ws + OFF_H), D, S, epi);
}

struct EpiOut {
    bf16_t* XD; const float* mod_l;
    __device__ __forceinline__ void operator()(const g8::Acc& acc, const g8::Unit& u, int wr, int wc, int fr, int fq) const {
        const float* g = mod_l + (size_t)tok_batch(u.pm * 256) * 6 * D + 2 * D;
        f32x4 gv[2][2];
        const bool uni = (NL % 256 == 0) && (S % 256 == 0) && (L % 256 == 0);
        if (uni) {
#pragma unroll
            for (int bj = 0; bj < 2; ++bj)
#pragma unroll
                for (int n = 0; n < 2; ++n) gv[bj][n] = *(const f32x4*)(g + u.pn * 256 + bj * 128 + wc * 32 + 16 * n + 4 * fq);
        }
#pragma unroll
        for (int ai = 0; ai < 2; ++ai)
#pragma unroll
            for (int m = 0; m < 4; ++m) {
                const int row = u.pm * 256 + ai * 128 + wr * 64 + m * 16 + fr;
                const float* gr = mod_l + (size_t)tok_batch(row) * 6 * D + 2 * D;
#pragma unroll
                for (int bj = 0; bj < 2; ++bj)
#pragma unroll
                    for (int n = 0; n < 2; ++n) {
                        const int c = u.pn * 256 + bj * 128 + wc * 32 + 16 * n + 4 * fq;
                        const f32x4 gq = uni ? gv[bj][n] : *(const f32x4*)(gr + c); const f32x4 a = acc[ai][bj][m][n];
                        u32x2 o; o[0] = pack2(gq[0] * a[0], gq[1] * a[1]); o[1] = pack2(gq[2] * a[2], gq[3] * a[3]);
                        *(u32x2*)(XD + (size_t)row * D + c) = o;
                    }
            }
    }
};
struct OneUnitOrder {
    int pm, pn; const bf16_t* Bt; int K;
    __device__ __forceinline__ bool next(int i, g8::Unit& u) const { if (i > 0) return false; u.pm = pm; u.pn = pn; u.bt = Bt + (size_t)pn * g8::BM * K; u.e = 0; return true; }
    __device__ __forceinline__ int arow(const g8::Unit& u, int r) const { return u.pm * g8::BM + r; }
};
__device__ void phase_gemm_out(const PP& p, int l, char* lds) {
    const int M = NL;
    g8::DenseOrder S; S.init(M, D, MIXW, (const bf16_t*)(p.ws + OFF_WOUT) + (size_t)l * D * MIXW, GDIM(), BID());
    EpiOut epi{(bf16_t*)(p.ws + OFF_XD), (const float*)(p.ws + OFF_MOD) + (size_t)l * (NB + 1) * 6 * D};
    g8::gemm_phase(lds, (const bf16_t*)(p.ws + OFF_MIX), MIXW, S, epi);
}

struct MoeOrder {
    const int* ps; const int* cn; const int* list; const bf16_t* W; int nN, K, nwg, G, c; size_t wstride; int up;
    __device__ __forceinline__ bool next(int i, g8::Unit& u) const {
        const long Lx = (long)i * G + c; if (Lx >= nwg) return false;
        const int mt = (int)Lx / nN; u.pn = (int)Lx % nN; u.pm = mt;
        int e = 0; while (e < NEXP - 1 && ps[e + 1] <= mt * 256) ++e;
        u.e = e; u.bt = W + (size_t)e * wstride + (size_t)u.pn * 256 * K; return true;
    }
    __device__ __forceinline__ int arow(const g8::Unit& u, int r) const {
        if (!up) return u.pm * 256 + r;
        int s = u.pm * 256 - ps[u.e] + r; const int cnt = cn[u.e]; s = s < cnt ? s : cnt - 1;
        return list[(size_t)u.e * NT + s];
    }
};
struct EpiUp {
    bf16_t* act; const int* ps; const int* cn;
    __device__ __forceinline__ void operator()(const g8::Acc& acc, const g8::Unit& u, int wr, int wc, int fr, int fq) const {
        const int lim = ps[u.e] + cn[u.e];
#pragma unroll
        for (int ai = 0; ai < 2; ++ai)
#pragma unroll
            for (int m = 0; m < 4; ++m) {
                const int row = u.pm * 256 + ai * 128 + wr * 64 + m * 16 + fr;
                if (row < lim) {
#pragma unroll
                    for (int bj = 0; bj < 2; ++bj) {
                        const int c = u.pn * 256 + bj * 128 + wc * 32 + 4 * fq;
                        const int j = (c >> 5) * 16 + (c & 15);
                        const f32x4 g = acc[ai][bj][m][0], uu = acc[ai][bj][m][1];
                        u32x2 o; o[0] = pack2(silu_fast(g[0]) * uu[0], silu_fast(g[1]) * uu[1]); o[1] = pack2(silu_fast(g[2]) * uu[2], silu_fast(g[3]) * uu[3]);
                        *(u32x2*)(act + (size_t)row * EH + j) = o;
                    }
                }
            }
    }
};
struct EpiDown {
    bf16_t* y; const int* ps; const int* cn;
    __device__ __forceinline__ void operator()(const g8::Acc& acc, const g8::Unit& u, int wr, int wc, int fr, int fq) const {
        const int lim = ps[u.e] + cn[u.e];
#pragma unroll
        for (int ai = 0; ai < 2; ++ai)
#pragma unroll
            for (int m = 0; m < 4; ++m) {
                const int row = u.pm * 256 + ai * 128 + wr * 64 + m * 16 + fr;
                if (row < lim) {
#pragma unroll
                    for (int bj = 0; bj < 2; ++bj)
#pragma unroll
                        for (int n = 0; n < 2; ++n) {
                            const int c = u.pn * 256 + bj * 128 + wc * 32 + 16 * n + 4 * fq; const f32x4 a = acc[ai][bj][m][n];
                            u32x2 o; o[0] = pack2(a[0], a[1]); o[1] = pack2(a[2], a[3]);
                            *(u32x2*)(y + (size_t)row * D + c) = o;
                        }
                }
            }
    }
};
template <int UP>
__device__ void phase_moe(const PP& p, int l, char* lds) {
    int* ps = (int*)(lds + g8::STAGE_BYTES);
    int* cn = ps + 40;
    __syncthreads();
    load_pad_start(p, l, ps);
    if (TID() < NEXP) cn[TID()] = ((const int*)(p.ws + OFF_CNT))[l * NEXP + TID()];
    __syncthreads();
    MoeOrder S; S.ps = ps; S.cn = cn; S.list = (const int*)(p.ws + OFF_LIST); S.G = GDIM(); S.c = BID(); S.up = UP;
    if (UP) { S.nN = 2 * EH / 256; S.K = D; S.W = (const bf16_t*)(p.ws + OFF_WUP) + (size_t)l * NEXP * 2 * EH * D; S.wstride = (size_t)2 * EH * D; }
    else { S.nN = D / 256; S.K = EH; S.W = (const bf16_t*)(p.ws + OFF_WDN) + (size_t)l * NEXP * D * EH; S.wstride = (size_t)D * EH; }
    S.nwg = (ps[NEXP] / 256) * S.nN;
    if (UP) { EpiUp epi{(bf16_t*)(p.ws + OFF_ACT), ps, cn}; g8::gemm_phase(lds, (const bf16_t*)(p.ws + OFF_H), D, S, epi); }
    else { EpiDown epi{(bf16_t*)(p.ws + OFF_Y), ps, cn}; g8::gemm_phase(lds, (const bf16_t*)(p.ws + OFF_ACT), EH, S, epi); }
}

template <int NMAP, int DV> struct AttnLds {
    static constexpr int RB = NMAP * 128, VSTR = DV * 2;
    static constexpr int Q_BYTES = 256 * RB, K_BYTES = 64 * RB, V_BYTES = 64 * VSTR, TOTAL = Q_BYTES + 2 * K_BYTES + 2 * V_BYTES;
};
#ifdef EMU
__device__ __forceinline__ bf16x4 tr_read_b64(const char* addr) {
    const char* a = addr; char* b = emu::wave_xchg(&a, sizeof(a));
    const int lane = threadIdx.x & 63, g = lane >> 4, i = lane & 15; bf16x4 r;
    for (int q = 0; q < 4; ++q) { const char* src = *(const char**)(b + (size_t)(16 * g + 4 * q + (i >> 2)) * 64); r[q] = *(const short*)(src + 2 * (i & 3)); }
    return r;
}
#define TR_READ(dst, base, OFF) dst = tr_read_b64((base) + (OFF))
#define LGKM_WAIT0() do {} while (0)
#define LGKM_WAITN(n) do {} while (0)
#else
#define TR_READ(dst, base, OFF) dst = __builtin_amdgcn_ds_read_tr16_b64_v4i16((LAS3 bf16x4*)((base) + (OFF)))
#define LGKM_WAIT0() do {} while (0)
#define LGKM_WAITN(n) do {} while (0)
#endif

struct MaskNone { __device__ __forceinline__ bool tile_valid(int) const { return true; } __device__ __forceinline__ float operator()(float s, int, int) const { return s; } };
struct MaskNA {
    const float* bias;
    int rq, cq, rs, rlo;
    __device__ __forceinline__ bool tile_valid(int kt) const { if (kt < LC) return true; const int kr = rlo + kt - LC; return kr >= rs && kr < rs + 8; }
    __device__ __forceinline__ float operator()(float s, int kt, int kc) const {
        if (kt < LC) return s;
        const int kr = rlo + kt - LC;
        int cs = cq - 8; cs = cs < 0 ? 0 : (cs > 48 ? 48 : cs);
        if (kc < cs || kc >= cs + 16) return -INFINITY;
        int dc = kc - cq; dc = dc < -15 ? -15 : (dc > 15 ? 15 : dc);
        return s + bias[(kr - rq + 7) * 31 + dc + 15];
    }
};

constexpr float ATTN_THR = 11.0f;

template <int NMAP, int DV, class KTok, class MaskF>
__device__ void attn_item(const PP& p, char* lds, int q0, int nq, int nkt, KTok ktok, int qcol, int kcol, int vcol, int ocol, MaskF mask, int layer) {
    typedef AttnLds<NMAP, DV> LL;
    constexpr int RB = LL::RB, VSTR = LL::VSTR, NDB = DV / 32;
    constexpr int KCH = 64 * RB / 16 / NTHREADS, VCH = 64 * DV / 8 / NTHREADS;
    const bf16_t* P = (const bf16_t*)(p.ws + OFF_P);
    bf16_t* MIX = (bf16_t*)(p.ws + OFF_MIX);
    char* Qs = lds; char* Ks = lds + LL::Q_BYTES; char* Vs = Ks + 2 * LL::K_BYTES;
    const int tid = TID(), lane = tid & 63, wave = tid >> 6, r32 = lane & 31, hh = lane >> 5;
    const bool active = wave * 32 < nq;
    __syncthreads();
    for (int c = tid; c < 256 * RB / 16; c += NTHREADS) {
        const int row = c / (RB / 16), ch = c % (RB / 16);
        u32x4 v = {0u, 0u, 0u, 0u};
        if (row < nq) v = *(const u32x4*)(P + (size_t)(q0 + row) * PW + qcol + ch * 8);
        *(u32x4*)(Qs + row * RB + ((ch * 16) ^ ((row & 7) << 4))) = v;
    }
    const int wid = READFIRSTLANE(wave);
    constexpr int KI = LL::K_BYTES / 1024 / 8, VI = LL::V_BYTES / 1024 / 8;
    constexpr int KCPR = RB / 16, VCPR = VSTR / 16;
#define A_KGO(i) ({ const int slot_ = (wid * KI + (i)) * 64 + lane, row_ = slot_ / KCPR, ch_ = (slot_ % KCPR) ^ (row_ & 7); row_ * PW + kcol + ch_ * 8; })
#define A_VGO(i) ({ const int slot_ = (wid * VI + (i)) * 64 + lane, row_ = slot_ / VCPR; const int sw_ = DV == 128 ? ((row_ & 3) << 2) : (((row_ >> 1) & 1) << 2); row_ * PW + vcol + (((slot_ % VCPR) ^ sw_) * 8); })
#define A_LOAD(kt_, b_) do { const bf16_t* t0_ = P + (size_t)ktok(kt_) * PW; \
        _Pragma("unroll") for (int i = 0; i < KI; ++i) GLDS16_ASM(t0_ + A_KGO(i), Ks + (b_) * LL::K_BYTES + (wid * KI + i) * 1024); \
        _Pragma("unroll") for (int i = 0; i < VI; ++i) GLDS16_ASM(t0_ + A_VGO(i), Vs + (b_) * LL::V_BYTES + (wid * VI + i) * 1024); } while (0)
    const int kx = (hh * 16) ^ ((r32 & 7) << 4);
#define koff_(ks) (kx ^ ((ks) * 32))
    const char* qrow = Qs + (wave * 32 + r32) * RB;
    const int g16 = lane >> 4, i16 = lane & 15;
    const int vq = i16 >> 2, vsw = DV == 128 ? vq : ((vq >> 1) & 1);
    const int vb0 = (4 * hh + vq) * VSTR + 32 * (g16 & 1) + 8 * (i16 & 3);
#define vbd_(d) (vb0 + (((d) ^ vsw) << 6))
    f32x16 O[NMAP][NDB];
    float mrun[NMAP], lrun[NMAP];
#pragma unroll
    for (int m = 0; m < NMAP; ++m) { mrun[m] = -1e30f; lrun[m] = 0.f;
#pragma unroll
        for (int d = 0; d < NDB; ++d)
#pragma unroll
            for (int i = 0; i < 16; ++i) O[m][d][i] = 0.f; }
    A_LOAD(0, 0);
    WAIT_V(0);
    __syncthreads();
    bf16x8 qfr[NMAP][4];
#pragma unroll
    for (int m = 0; m < NMAP; ++m)
#pragma unroll
        for (int ks = 0; ks < 4; ++ks) qfr[m][ks] = *(const bf16x8*)(qrow + m * 128 + koff_(ks));
    for (int kt = 0; kt < nkt; ++kt) {
        const int b = kt & 1;
        if (kt + 1 < nkt) A_LOAD(kt + 1, b ^ 1);
        if (active && mask.tile_valid(kt)) {
            const char* Kb = Ks + b * LL::K_BYTES; const char* Vb = Vs + b * LL::V_BYTES;
#pragma unroll
            for (int kb = 0; kb < 2; ++kb) {
                bf16x8 pf[NMAP][2];
#pragma unroll
                for (int m = 0; m < NMAP; ++m) {
                    f32x16 st;
#pragma unroll
                    for (int i = 0; i < 16; ++i) st[i] = 0.f;
#pragma unroll
                    for (int ks = 0; ks < 4; ++ks) {
                        const bf16x8 a = *(const bf16x8*)(Kb + (kb * 32 + r32) * RB + m * 128 + koff_(ks));
                        st = MFMA32(a, qfr[m][ks], st);
                    }
                    float mx = -INFINITY;
#pragma unroll
                    for (int i = 0; i < 16; ++i) { const int kc = kb * 32 + (i & 3) + 8 * (i >> 2) + 4 * hh; const float sv = mask(st[i], kt, kc); st[i] = sv; mx = fmaxf(mx, sv); }
                    mx = xhalf_max(mx);
                    if (!__all(mx - mrun[m] <= ATTN_THR)) {
                        const float mnew = fmaxf(mrun[m], mx), alpha = EXP2F(mrun[m] - mnew);
                        mrun[m] = mnew; lrun[m] *= alpha;
#pragma unroll
                        for (int d = 0; d < NDB; ++d)
#pragma unroll
                            for (int i = 0; i < 16; ++i) O[m][d][i] *= alpha;
                    }
                    const float mr = mrun[m];
                    float ls = 0.f;
#pragma unroll
                    for (int s2 = 0; s2 < 2; ++s2) {
                        u32x4 pk;
#pragma unroll
                        for (int j = 0; j < 4; ++j) { const float p0 = EXP2F(st[8 * s2 + 2 * j] - mr), p1 = EXP2F(st[8 * s2 + 2 * j + 1] - mr); ls += p0 + p1; pk[j] = pack2(p0, p1); }
                        pf[m][s2] = __builtin_bit_cast(bf16x8, pk);
                    }
                    lrun[m] += ls;
                }
                bf16x4 va[2][4];
#define A_TR(set_, d_) do { TR_READ(va[set_][0], Vb + vbd_(d_), (kb * 32) * VSTR); TR_READ(va[set_][1], Vb + vbd_(d_), (kb * 32 + 8) * VSTR); \
                            TR_READ(va[set_][2], Vb + vbd_(d_), (kb * 32 + 16) * VSTR); TR_READ(va[set_][3], Vb + vbd_(d_), (kb * 32 + 24) * VSTR); } while (0)
#pragma unroll
                for (int d = 0; d < NDB; ++d) {
                    A_TR(0, d); LGKM_WAITN(0);
                    const bf16x4* v_ = va[0];
                    const bf16x8 av0 = {v_[0][0], v_[0][1], v_[0][2], v_[0][3], v_[1][0], v_[1][1], v_[1][2], v_[1][3]};
                    const bf16x8 av1 = {v_[2][0], v_[2][1], v_[2][2], v_[2][3], v_[3][0], v_[3][1], v_[3][2], v_[3][3]};
                    SETPRIO(1);
#pragma unroll
                    for (int m = 0; m < NMAP; ++m) O[m][d] = MFMA32(av0, pf[m][0], O[m][d]);
#pragma unroll
                    for (int m = 0; m < NMAP; ++m) O[m][d] = MFMA32(av1, pf[m][1], O[m][d]);
                    SETPRIO(0);
                }
#undef A_TR
            }
        }
        WAIT_V(0);
        __syncthreads();
    }
#undef A_LOAD
#undef A_KGO
#undef A_VGO
#undef koff_
#undef vbd_
    if (active) {
        float lam = 0.f, post_scale = 1.0f; const float* g_sub = p.sm(OFF_S_GSUB) + (size_t)layer * 128;
        if (NMAP == 2) {
            const float lam_init = 0.8f - 0.6f * expf(-0.3f * (float)layer);
            const float* lm = p.sm(OFF_S_LAM) + (size_t)layer * 4 * 64; float a = 0.f, b2 = 0.f;
            for (int i = 0; i < 64; ++i) { a += lm[i] * lm[64 + i]; b2 += lm[128 + i] * lm[192 + i]; }
            lam = expf(a) - expf(b2) + lam_init; post_scale = 1.0f - lam_init;
        }
        float inv[NMAP];
#pragma unroll
        for (int m = 0; m < NMAP; ++m) { const float lt = xhalf_sum(lrun[m]); inv[m] = 1.0f / lt; }
        float ss = 0.f;
#pragma unroll
        for (int d = 0; d < NDB; ++d)
#pragma unroll
            for (int i = 0; i < 16; ++i) {
                float o = O[0][d][i] * inv[0];
                if (NMAP == 2) o -= lam * O[NMAP - 1][d][i] * inv[NMAP - 1];
                O[0][d][i] = o; ss += o * o;
            }
        float rs = 1.0f;
        if (NMAP == 2) { ss = xhalf_sum(ss); rs = post_scale / sqrtf(ss / (float)DV + NORM_EPS); }
        const int tok = q0 + wave * 32 + r32;
#pragma unroll
        for (int d = 0; d < NDB; ++d)
#pragma unroll
            for (int g = 0; g < 4; ++g) {
                const int dd = d * 32 + 8 * g + 4 * hh;
                float v0 = O[0][d][4 * g] * rs, v1 = O[0][d][4 * g + 1] * rs, v2 = O[0][d][4 * g + 2] * rs, v3 = O[0][d][4 * g + 3] * rs;
                if (NMAP == 2) { v0 *= g_sub[dd]; v1 *= g_sub[dd + 1]; v2 *= g_sub[dd + 2]; v3 *= g_sub[dd + 3]; }
                u32x2 o; o[0] = pack2(v0, v1); o[1] = pack2(v2, v3);
                *(u32x2*)(MIX + (size_t)tok * MIXW + ocol + dd) = o;
            }
    }
}

struct KTokDiff { int b; __device__ __forceinline__ int operator()(int kt) const { return kt < LC ? NL + b * L + kt * 64 : b * S + (kt - LC) * 64; } };
struct KTokCtx { int b; __device__ __forceinline__ int operator()(int kt) const { return NL + b * L + kt * 64; } };
struct KTokNA { int b, rlo; __device__ __forceinline__ int operator()(int kt) const { return kt < LC ? NL + b * L + kt * 64 : b * S + (rlo + kt - LC) * 64; } };

constexpr int GL_QS = 80;
constexpr int GL_VS = 192;
constexpr int GL_OP = 64 * GL_QS;
constexpr int GL_DIR = 4 * GL_OP + 64 * GL_VS + 2 * GL_OP + 256;
constexpr int GL_WD = 2 * (16 * 32 + 32) * 4;
constexpr int GLA_LDS = 2 * GL_DIR + GL_WD + 256;
constexpr size_t OPART_CH = 4096;

__device__ __forceinline__ int gla_chunk_tok(int b, int c) { return c < LC ? NL + b * L + c * 64 : b * S + (c - LC) * 64; }
__device__ __forceinline__ int gla_bwd_chunk(int i) { return i < LC ? LC - 1 - i : NCH - 1 - (i - LC); }
__device__ __forceinline__ int gla_bwd_step(int c) { return c < LC ? LC - 1 - c : LC + NCH - 1 - c; }

__device__ void gla_chain_item(const PP& p, int l, int b, int h, char* lds) {
    const int tid = TID(), lane = tid & 63, wave = tid >> 6, r32 = lane & 31, hh = lane >> 5, g16 = lane >> 4, i16 = lane & 15;
    const bf16_t* P = (const bf16_t*)(p.ws + OFF_P);
    bf16_t* MIX = (bf16_t*)(p.ws + OFF_MIX);
    float* OPART = (float*)(p.ws + OFF_GKV) + (size_t)(b * 4 + h) * 2 * NCH * OPART_CH;
    float* wdl = (float*)(lds + 2 * GL_DIR);
    const int pd = wave >> 2, pq = wave & 3, tl = pd == 0 ? lane : 63 - lane;
    char* L_own = lds + pd * GL_DIR;
    __syncthreads();
    for (int e = tid; e < 2 * 16 * 32; e += NTHREADS) { const int d = e >> 9, r = (e >> 5) & 15, k = e & 31; wdl[e] = p.sm(OFF_S_WDEC)[(((size_t)l * 2 + d) * 16 + r) * 128 + h * 32 + k]; }
    if (tid < 64) { const int d = tid >> 5, k = tid & 31; wdl[1024 + tid] = p.sm(OFF_S_BDEC)[((size_t)l * 2 + d) * 128 + h * 32 + k]; }
    for (int e = tid; e < 2 * GL_OP / 4; e += NTHREADS) { const int d = e / (GL_OP / 4), o = e % (GL_OP / 4); ((unsigned*)(lds + d * GL_DIR + 4 * GL_OP + 64 * GL_VS))[o] = 0u; }
    __syncthreads();
    u32x4 rq, rk, rg0, rg1, rv0, rv1;
    const int vid0 = pq * 64 + lane, vid1 = vid0 + 256;
#define GL_FETCH(step_) do { const int c_ = pd == 0 ? (step_) : gla_bwd_chunk(step_); const bf16_t* base_ = P + (size_t)gla_chunk_tok(b, c_) * PW; \
        const bf16_t* row_ = base_ + (size_t)tl * PW; \
        rq = *(const u32x4*)(row_ + C_QB + h * 32 + pq * 8); rk = *(const u32x4*)(row_ + C_KB + h * 32 + pq * 8); \
        rg0 = *(const u32x4*)(row_ + C_GB + pd * 16); rg1 = *(const u32x4*)(row_ + C_GB + pd * 16 + 8); \
        rv0 = *(const u32x4*)(base_ + (size_t)(vid0 >> 3) * PW + C_VB + h * 64 + (vid0 & 7) * 8); \
        rv1 = *(const u32x4*)(base_ + (size_t)(vid1 >> 3) * PW + C_VB + h * 64 + (vid1 & 7) * 8); } while (0)
    GL_FETCH(0);
    const bool out_role = wave < 4;
    const int cd = out_role ? (wave >> 1) : ((wave - 4) >> 1), cblk = wave & 1;
    char* L_c = lds + cd * GL_DIR;
    f32x16 Sst;
#pragma unroll
    for (int i = 0; i < 16; ++i) Sst[i] = 0.f;
    for (int step = 0; step < NCH; ++step) {
        {
            float gv[16];
            { const unsigned gw[8] = {rg0[0], rg0[1], rg0[2], rg0[3], rg1[0], rg1[1], rg1[2], rg1[3]};
#pragma unroll
              for (int j = 0; j < 8; ++j) { gv[2 * j] = u2f(gw[j] << 16); gv[2 * j + 1] = u2f(gw[j] & 0xffff0000u); } }
            float bb[8];
            const float* wdp = wdl + pd * 512 + pq * 8;
#pragma unroll
            for (int j = 0; j < 8; ++j) bb[j] = wdl[1024 + pd * 32 + pq * 8 + j];
#pragma unroll
            for (int r = 0; r < 16; ++r) { const f32x4 w0 = *(const f32x4*)(wdp + r * 32), w1 = *(const f32x4*)(wdp + r * 32 + 4);
                bb[0] += gv[r] * w0[0]; bb[1] += gv[r] * w0[1]; bb[2] += gv[r] * w0[2]; bb[3] += gv[r] * w0[3];
                bb[4] += gv[r] * w1[0]; bb[5] += gv[r] * w1[1]; bb[6] += gv[r] * w1[2]; bb[7] += gv[r] * w1[3]; }
#pragma unroll
            for (int j = 0; j < 8; ++j) bb[j] = log_sigmoid_fast(bb[j]) * (1.0f / 16.0f);
#pragma unroll
            for (int o = 1; o < 64; o <<= 1) {
#pragma unroll
                for (int j = 0; j < 8; ++j) { const float t = __shfl_up(bb[j], o); if (lane >= o) bb[j] += t; }
            }
            float qv[8], kv[8];
            { const unsigned qw[4] = {rq[0], rq[1], rq[2], rq[3]}, kw_[4] = {rk[0], rk[1], rk[2], rk[3]};
#pragma unroll
              for (int j = 0; j < 4; ++j) { qv[2 * j] = u2f(qw[j] << 16); qv[2 * j + 1] = u2f(qw[j] & 0xffff0000u); kv[2 * j] = u2f(kw_[j] << 16); kv[2 * j + 1] = u2f(kw_[j] & 0xffff0000u); } }
            float e_qe[8], e_ke[8], e_qf[8], e_kw[8];
#pragma unroll
            for (int j = 0; j < 8; ++j) {
                const float bref = __shfl(bb[j], 31), bend = __shfl(bb[j], 63);
                e_qe[j] = qv[j] * exp_fast(bb[j] - bref); e_ke[j] = kv[j] * exp_fast(bref - bb[j]); e_qf[j] = qv[j] * exp_fast(bb[j]); e_kw[j] = kv[j] * exp_fast(bend - bb[j]);
                if (lane == 63) ((float*)(L_own + 4 * GL_OP + 64 * GL_VS + 2 * GL_OP))[pq * 8 + j] = exp_fast(bend);
            }
            char* rowp = L_own + tl * GL_QS + pq * 16;
            u32x4 o;
            o = (u32x4){pack2(e_qe[0], e_qe[1]), pack2(e_qe[2], e_qe[3]), pack2(e_qe[4], e_qe[5]), pack2(e_qe[6], e_qe[7])}; *(u32x4*)(rowp) = o;
            o = (u32x4){pack2(e_ke[0], e_ke[1]), pack2(e_ke[2], e_ke[3]), pack2(e_ke[4], e_ke[5]), pack2(e_ke[6], e_ke[7])}; *(u32x4*)(rowp + GL_OP) = o;
            o = (u32x4){pack2(e_qf[0], e_qf[1]), pack2(e_qf[2], e_qf[3]), pack2(e_qf[4], e_qf[5]), pack2(e_qf[6], e_qf[7])}; *(u32x4*)(rowp + 2 * GL_OP) = o;
            o = (u32x4){pack2(e_kw[0], e_kw[1]), pack2(e_kw[2], e_kw[3]), pack2(e_kw[4], e_kw[5]), pack2(e_kw[6], e_kw[7])}; *(u32x4*)(rowp + 3 * GL_OP) = o;
            *(u32x4*)(L_own + 4 * GL_OP + (vid0 >> 3) * GL_VS + (vid0 & 7) * 16) = rv0;
            *(u32x4*)(L_own + 4 * GL_OP + (vid1 >> 3) * GL_VS + (vid1 & 7) * 16) = rv1;
        }
        if (step + 1 < NCH) GL_FETCH(step + 1);
        float th[2][16]; u32x2 rgv[2][4];
        bool fin = false; int fcc = 0, ftok = 0;
        if (out_role) {
            fcc = cd == 0 ? step : gla_bwd_chunk(step);
            const int other_step = cd == 0 ? gla_bwd_step(fcc) : fcc;
            fin = other_step < step;
            ftok = gla_chunk_tok(b, fcc) + cblk * 32 + r32;
            if (fin) {
                const float* theirs = OPART + ((size_t)(1 - cd) * NCH + fcc) * OPART_CH;
                const bf16_t* rg = P + (size_t)ftok * PW + C_RB + h * 64;
#pragma unroll
                for (int vb = 0; vb < 2; ++vb) {
#pragma unroll
                    for (int i = 0; i < 16; ++i) th[vb][i] = theirs[(vb * 32 + (i & 3) + 8 * (i >> 2) + 4 * hh) * 64 + cblk * 32 + r32];
#pragma unroll
                    for (int g = 0; g < 4; ++g) rgv[vb][g] = *(const u32x2*)(rg + vb * 32 + 8 * g + 4 * hh);
                }
            }
        }
        __syncthreads();
        const int cc = cd == 0 ? step : gla_bwd_chunk(step);
        const char* Lqe = L_c, * Lke = L_c + GL_OP, * Lqf = L_c + 2 * GL_OP, * Lkw = L_c + 3 * GL_OP, * Lv = L_c + 4 * GL_OP;
        const char* Lsr = L_c + 4 * GL_OP + 64 * GL_VS + (step & 1) * GL_OP;
        char* Lsw = L_c + 4 * GL_OP + 64 * GL_VS + ((step + 1) & 1) * GL_OP;
        if (out_role) {
            bf16x8 pf[2][2];
#pragma unroll
            for (int sb = 0; sb < 2; ++sb) {
                f32x16 at;
#pragma unroll
                for (int i = 0; i < 16; ++i) at[i] = 0.f;
#pragma unroll
                for (int ks = 0; ks < 2; ++ks) {
                    const bf16x8 a = *(const bf16x8*)(Lke + (sb * 32 + r32) * GL_QS + ks * 32 + hh * 16);
                    const bf16x8 bq = *(const bf16x8*)(Lqe + (cblk * 32 + r32) * GL_QS + ks * 32 + hh * 16);
                    at = MFMA32(a, bq, at);
                }
                const int tt = cblk * 32 + r32;
#pragma unroll
                for (int s2 = 0; s2 < 2; ++s2) {
                    u32x4 pk;
#pragma unroll
                    for (int j = 0; j < 4; ++j) {
                        const int s0 = sb * 32 + ((8 * s2 + 2 * j) & 3) + 8 * ((8 * s2 + 2 * j) >> 2) + 4 * hh, s1 = s0 + 1;
                        const bool k0 = cd == 0 ? (s0 <= tt) : (s0 >= tt), k1 = cd == 0 ? (s1 <= tt) : (s1 >= tt);
                        pk[j] = pack2(k0 ? at[8 * s2 + 2 * j] : 0.f, k1 ? at[8 * s2 + 2 * j + 1] : 0.f);
                    }
                    pf[sb][s2] = __builtin_bit_cast(bf16x8, pk);
                }
            }
            f32x16 oacc[2];
            const int vb_ = (4 * hh + (i16 >> 2)) * GL_VS + (16 * (g16 & 1) + 4 * (i16 & 3)) * 2;
#pragma unroll
            for (int vb = 0; vb < 2; ++vb) {
#pragma unroll
                for (int i = 0; i < 16; ++i) oacc[vb][i] = 0.f;
#pragma unroll
                for (int ks = 0; ks < 2; ++ks) {
                    const bf16x8 a = *(const bf16x8*)(Lsr + (vb * 32 + r32) * GL_QS + ks * 32 + hh * 16);
                    const bf16x8 bq = *(const bf16x8*)(Lqf + (cblk * 32 + r32) * GL_QS + ks * 32 + hh * 16);
                    oacc[vb] = MFMA32(a, bq, oacc[vb]);
                }
                bf16x4 lo[2][2], hi[2][2];
#pragma unroll
                for (int sb = 0; sb < 2; ++sb)
#pragma unroll
                    for (int s2 = 0; s2 < 2; ++s2) {
                        TR_READ(lo[sb][s2], Lv + vb_, vb * 64 + (sb * 32 + s2 * 16) * GL_VS);
                        TR_READ(hi[sb][s2], Lv + vb_, vb * 64 + (sb * 32 + s2 * 16 + 8) * GL_VS);
                    }
                LGKM_WAIT0();
#pragma unroll
                for (int sb = 0; sb < 2; ++sb)
#pragma unroll
                    for (int s2 = 0; s2 < 2; ++s2) {
                        const bf16x8 av = {lo[sb][s2][0], lo[sb][s2][1], lo[sb][s2][2], lo[sb][s2][3], hi[sb][s2][0], hi[sb][s2][1], hi[sb][s2][2], hi[sb][s2][3]};
                        oacc[vb] = MFMA32(av, pf[sb][s2], oacc[vb]);
                    }
            }
            const int tt = cblk * 32 + r32;
            float* mine = OPART + ((size_t)cd * NCH + cc) * OPART_CH;
            if (!fin) {
#pragma unroll
                for (int vb = 0; vb < 2; ++vb)
#pragma unroll
                    for (int i = 0; i < 16; ++i) mine[(vb * 32 + (i & 3) + 8 * (i >> 2) + 4 * hh) * 64 + tt] = oacc[vb][i];
            } else {
                float ss = 0.f;
#pragma unroll
                for (int vb = 0; vb < 2; ++vb)
#pragma unroll
                    for (int i = 0; i < 16; ++i) { const float o = oacc[vb][i] + th[vb][i]; oacc[vb][i] = o; ss += o * o; }
                ss += __shfl_xor(ss, 32);
                const float rstd = 1.0f / sqrtf(ss / 64.0f + NORM_EPS);
                const float* gg = p.sm(OFF_S_GGLA) + l * 64;
#pragma unroll
                for (int vb = 0; vb < 2; ++vb)
#pragma unroll
                    for (int g = 0; g < 4; ++g) {
                        const int v0 = vb * 32 + 8 * g + 4 * hh;
                        const u32x2 rr = rgv[vb][g];
                        const float r0 = u2f(rr[0] << 16), r1 = u2f(rr[0] & 0xffff0000u), r2 = u2f(rr[1] << 16), r3 = u2f(rr[1] & 0xffff0000u);
                        u32x2 o;
                        o[0] = pack2(oacc[vb][4 * g] * rstd * gg[v0] * silu_fast(r0), oacc[vb][4 * g + 1] * rstd * gg[v0 + 1] * silu_fast(r1));
                        o[1] = pack2(oacc[vb][4 * g + 2] * rstd * gg[v0 + 2] * silu_fast(r2), oacc[vb][4 * g + 3] * rstd * gg[v0 + 3] * silu_fast(r3));
                        *(u32x2*)(MIX + (size_t)ftok * MIXW + 512 + h * 64 + v0) = o;
                    }
            }
        } else {
            const float dec = ((const float*)(L_c + 4 * GL_OP + 64 * GL_VS + 2 * GL_OP))[r32];
#pragma unroll
            for (int i = 0; i < 16; ++i) Sst[i] *= dec;
            const int rb_ = (8 * hh + (i16 >> 2));
            const int va_ = rb_ * GL_VS + (16 * (g16 & 1) + 4 * (i16 & 3)) * 2 + cblk * 64;
            const int kb_ = rb_ * GL_QS + (16 * (g16 & 1) + 4 * (i16 & 3)) * 2;
            bf16x4 alo[4], ahi[4], blo[4], bhi[4];
#pragma unroll
            for (int ks = 0; ks < 4; ++ks) {
                TR_READ(alo[ks], Lv + va_, (ks * 16) * GL_VS); TR_READ(ahi[ks], Lv + va_, (ks * 16 + 4) * GL_VS);
                TR_READ(blo[ks], Lkw + kb_, (ks * 16) * GL_QS); TR_READ(bhi[ks], Lkw + kb_, (ks * 16 + 4) * GL_QS);
            }
            LGKM_WAIT0();
#pragma unroll
            for (int ks = 0; ks < 4; ++ks) {
                const bf16x8 av = {alo[ks][0], alo[ks][1], alo[ks][2], alo[ks][3], ahi[ks][0], ahi[ks][1], ahi[ks][2], ahi[ks][3]};
                const bf16x8 bv = {blo[ks][0], blo[ks][1], blo[ks][2], blo[ks][3], bhi[ks][0], bhi[ks][1], bhi[ks][2], bhi[ks][3]};
                Sst = MFMA32(av, bv, Sst);
            }
#pragma unroll
            for (int i = 0; i < 16; ++i) *(bf16_t*)(Lsw + (cblk * 32 + (i & 3) + 8 * (i >> 2) + 4 * hh) * GL_QS + r32 * 2) = f2bf(Sst[i]);
        }
        WAIT_V(0);
        __syncthreads();
    }
#undef GL_FETCH
}

__device__ void phase_mixers(const PP& pin, int l, char* lds) {
    PP p = pin;
    const bool need_ctx = l < DEPTH - 1;
    constexpr int QB_PER = S / 256, QC_PER = (L + 255) / 256;
    constexpr int N_GLA = NB * 4;
    constexpr int N_DIFF = NB * 4 * QB_PER, N_DIFFC = NB * 4 * QC_PER;
    constexpr int NA_BLK = IMG_ROWS / 4;
    constexpr int N_NA = NB * 4 * NA_BLK, N_NAC = NB * 4;
    int* qi = (int*)(lds - 8);
    int* qctr = (int*)(p.ws + OFF_CNT + 2048) + l * 64;
#define Q_NEXT(qn_, lim_, it_) { __syncthreads(); if (TID() == 0) *qi = atomicAdd(qctr + (qn_), 1); __syncthreads(); it_ = *qi; if (it_ >= (lim_)) break; \
        { int z_ = 0; LAUNDER_S(z_); p.ws = pin.ws + z_; } LAUNDER_S(l); }
    int* ctxdone = qctr + 24;
#ifdef EMU
#define CTX_DONE() do { __syncthreads(); if (TID() == 0) atomicAdd(ctxdone, 1); } while (0)
#else
#define CTX_DONE() do { asm volatile("s_waitcnt vmcnt(0)" ::: "memory"); __syncthreads(); if (TID() == 0) { __builtin_amdgcn_fence(__ATOMIC_RELEASE, "agent"); atomicAdd(ctxdone, 1); } } while (0)
#endif
    for (;;) { int it; Q_NEXT(0, N_GLA, it);
        gla_chain_item(p, l, it >> 2, it & 3, lds);
        if (need_ctx) CTX_DONE();
    }
#ifdef EMU
    const int myx = BID() & 7;
#else
    const int myx = (int)(xb_xcc_id() & 7u);
#endif
    constexpr int DPX = (NB * 4 / 8) * QB_PER;
    for (int xo = 0; xo < 8; ++xo) {
        const int xq = (myx + xo) & 7;
        for (;;) { int j; Q_NEXT(8 + xq, DPX, j);
            const int pr = xq + 8 * (j / QB_PER), qb = j % QB_PER, h = pr & 3, b = pr >> 2;
            attn_item<2, 128>(p, lds, b * S + qb * 256, 256, NCH, KTokDiff{b}, C_QA + h * 128, C_KA + h * 128, C_VA + h * 128, h * 128, MaskNone(), l);
        }
    }
    if (need_ctx) for (;;) { int j; Q_NEXT(2, N_DIFFC, j);
        const int qb = j % QC_PER, h = (j / QC_PER) & 3, b = j / (QC_PER * 4);
        attn_item<2, 128>(p, lds, NL + b * L + qb * 256, (L - qb * 256) < 256 ? (L - qb * 256) : 256, LC, KTokCtx{b}, C_QA + h * 128, C_KA + h * 128, C_VA + h * 128, h * 128, MaskNone(), l);
        CTX_DONE();
    }
    for (;;) { int j; Q_NEXT(3, N_NA, j);
        const int rb = j % NA_BLK, h = (j / NA_BLK) & 3, b = j / (NA_BLK * 4);
        const int r0 = rb * 4;
        auto rstart = [](int r) { int s = r - 4; return s < 0 ? 0 : (s > IMG_ROWS - 8 ? IMG_ROWS - 8 : s); };
        const int rlo = rstart(r0), rhi = rstart(r0 + 3) + 7;
        float* bias = (float*)(lds + AttnLds<1, 64>::TOTAL);
        __syncthreads();
        for (int e = TID(); e < 15 * 31; e += NTHREADS) bias[e] = p.sm(OFF_S_RPB)[((size_t)l * 4 + h) * 15 * 31 + e] * LOG2E;
        const int wave = TID() >> 6, lane = TID() & 63;
        const int rq = r0 + (wave >> 1), cq = (wave & 1) * 32 + (lane & 31);
        MaskNA mk{bias, rq, cq, rstart(rq), rlo};
        attn_item<1, 64>(p, lds, b * S + r0 * 64, 256, LC + (rhi - rlo + 1), KTokNA{b, rlo}, C_QN + h * 64, C_KN + h * 64, C_VN + h * 64, 768 + h * 64, mk, l);
    }
    if (need_ctx) for (;;) { int j; Q_NEXT(4, N_NAC, j);
        const int h = j & 3, b = j >> 2;
        attn_item<1, 64>(p, lds, NL + b * L, L, LC, KTokCtx{b}, C_QN + h * 64, C_KN + h * 64, C_VN + h * 64, 768 + h * 64, MaskNone(), l);
        CTX_DONE();
    }
    if (need_ctx) for (;;) { int j; Q_NEXT(6, (NC / 256) * (D / 256), j);
        if (TID() == 0) {
            unsigned sp = 0;
            while (atomicAdd(ctxdone, 0) < N_GLA + N_DIFFC + N_NAC) {
#ifdef EMU
                sched_yield();
#else
                __builtin_amdgcn_s_sleep(16);
#endif
                if (++sp > (1u << 24)) break;
            }
#ifndef EMU
            __builtin_amdgcn_fence(__ATOMIC_ACQUIRE, "agent");
            asm volatile("s_waitcnt vmcnt(0)" ::: "memory");
#endif
        }
        __syncthreads();
        OneUnitOrder S1; S1.pm = NL / 256 + j / (D / 256); S1.pn = j % (D / 256); S1.Bt = (const bf16_t*)(p.ws + OFF_WOUT) + (size_t)l * D * MIXW; S1.K = MIXW;
        EpiOut epi{(bf16_t*)(p.ws + OFF_XD), (const float*)(p.ws + OFF_MOD) + (size_t)l * (NB + 1) * 6 * D};
        g8::gemm_phase(lds, (const bf16_t*)(p.ws + OFF_MIX), MIXW, S1, epi);
    }
#undef CTX_DONE
#undef Q_NEXT
}

constexpr int cmax(int a, int b) { return a > b ? a : b; }
constexpr int LDS_BYTES = cmax(cmax(g8::STAGE_BYTES + 1024 + 8192, AttnLds<2, 128>::TOTAL), cmax(ROUTER_LDS, cmax(AttnLds<1, 64>::TOTAL + 2048, GLA_LDS))) + 16;

#ifndef MK_LAUNCHES
#define MK_LAUNCHES 1
#endif
template <int PT> __device__ __forceinline__ void run_phase(const Params& pin, int l, char* lds) {
    PP p; p.ws = pin.ws; p.out = pin.out; p.x = (PT == 1 || PT == 7 || PT == 10) ? pin.x : nullptr; p.ctx = (PT == 1 || PT == 7 || PT == 10) ? pin.ctx : nullptr;
    LAUNDER_GPTR(p.ws); LAUNDER_GPTR(p.out); LAUNDER_S(l);
    if (PT == 0) phase_prologue(pin, lds);
    if (PT == 1) phase_norm<0>(p, l, lds);
    if (PT == 2) phase_gemm_in(p, l, lds);
    if (PT == 5) { phase_mixers(p, l, lds); cvt_ahead(pin, l, lds); }
    if (PT == 6) phase_gemm_out(p, l, lds);
    if (PT == 7) phase_router(p, l, lds);
    if (PT == 8) phase_moe<1>(p, l, lds);
    if (PT == 9) phase_moe<0>(p, l, lds);
    if (PT == 10) phase_norm<2>(p, 0, lds);
}
template <int PT> __global__ void __launch_bounds__(NTHREADS, 2) k_phase(Params p, int l) {
    DYN_LDS(lds_raw);
    run_phase<PT>(p, l, lds_raw + 16);
}

#if MK_LAUNCHES == 1
__global__ void __launch_bounds__(NTHREADS, 2) mega(Params p) {
    DYN_LDS(lds_raw);
    char* lds = lds_raw + 16;
#ifdef EMU
    GridBar gb{(unsigned*)(p.ws + OFF_BAR)};
#else
    if (threadIdx.x == 0) *(uint4*)lds_raw = make_uint4(0u, 0u, 0u, 0u);
    __syncthreads();
    GridBar gb = xcd_barrier_post((unsigned*)(p.ws + OFF_BAR), (volatile LAS unsigned*)lds_raw);
#endif
    run_phase<0>(p, 0, lds); grid_barrier(gb);
    for (int l = 0; l < DEPTH; ++l) {
        run_phase<1>(p, l, lds); grid_barrier(gb);
        run_phase<2>(p, l, lds); grid_barrier(gb);
        run_phase<5>(p, l, lds); grid_barrier(gb);
        run_phase<6>(p, l, lds); grid_barrier(gb);
        run_phase<7>(p, l, lds); grid_barrier(gb);
        run_phase<8>(p, l, lds); grid_barrier(gb);
        run_phase<9>(p, l, lds); grid_barrier(gb);
    }
    run_phase<10>(p, 0, lds);
}
#endif


extern "C" void kernel_launch(void* const* d_in, const int* in_sizes, int n_in, void* d_out, int out_size, void* d_ws, size_t ws_size, hipStream_t stream) {
    (void)in_sizes; (void)n_in; (void)out_size; (void)ws_size;
    Params p;
    p.x = (const float*)d_in[0]; p.c = (const float*)d_in[1]; p.ctx = (const float*)d_in[2]; p.c_ctx = (const float*)d_in[3];
    p.w_mod = (const float*)d_in[4]; p.b_mod = (const float*)d_in[5]; p.g1 = (const float*)d_in[6]; p.g2 = (const float*)d_in[7];
    p.w_in = (const float*)d_in[8]; p.w_out = (const float*)d_in[9]; p.lam = (const float*)d_in[10]; p.g_sub = (const float*)d_in[11];
    p.w_dec = (const float*)d_in[12]; p.b_dec = (const float*)d_in[13]; p.g_gla = (const float*)d_in[14]; p.rpb = (const float*)d_in[15];
    p.w_rg = (const float*)d_in[16]; p.b_rg = (const float*)d_in[17]; p.w_re = (const float*)d_in[18]; p.b_re = (const float*)d_in[19];
    p.w_up = (const float*)d_in[20]; p.w_dn = (const float*)d_in[21]; p.g_fin = (const float*)d_in[22];
    p.out = (float*)d_out; p.ws = (char*)d_ws;
    (void)hipMemsetAsync(d_ws, 0, ZERO_BYTES, stream);
#ifdef EMU
    const int grid = emu::g_max_os_threads;
#define LAUNCH_PH(PT, l) do { auto t0 = std::chrono::steady_clock::now(); EMU_LAUNCH(k_phase<PT>, grid, NTHREADS, LDS_BYTES, stream, p, l); \
        fprintf(stderr, "  phase type %d layer %d: %.2f s\n", PT, l, std::chrono::duration<double>(std::chrono::steady_clock::now() - t0).count()); } while (0)
#if MK_LAUNCHES == 1
#define LAUNCH_MEGA() EMU_LAUNCH(mega, grid, NTHREADS, LDS_BYTES, stream, p)
#else
#define LAUNCH_MEGA() do {} while (0)
#endif
    const int hi = getenv("EMU_PH_HI") ? atoi(getenv("EMU_PH_HI")) : 1000;
#else
    static int grid = 0;
    if (!grid) {
        int dev = 0, cus = 0, per_cu = 0;
        (void)hipGetDevice(&dev);
        (void)hipDeviceGetAttribute(&cus, hipDeviceAttributeMultiprocessorCount, dev);
#if MK_LAUNCHES == 1
        (void)hipFuncSetAttribute((const void*)mega, hipFuncAttributeMaxDynamicSharedMemorySize, LDS_BYTES);
#endif
#if MK_LAUNCHES == 0
        (void)hipFuncSetAttribute((const void*)k_phase<0>, hipFuncAttributeMaxDynamicSharedMemorySize, LDS_BYTES);
        (void)hipFuncSetAttribute((const void*)k_phase<1>, hipFuncAttributeMaxDynamicSharedMemorySize, LDS_BYTES);
        (void)hipFuncSetAttribute((const void*)k_phase<2>, hipFuncAttributeMaxDynamicSharedMemorySize, LDS_BYTES);
        (void)hipFuncSetAttribute((const void*)k_phase<3>, hipFuncAttributeMaxDynamicSharedMemorySize, LDS_BYTES);
        (void)hipFuncSetAttribute((const void*)k_phase<4>, hipFuncAttributeMaxDynamicSharedMemorySize, LDS_BYTES);
        (void)hipFuncSetAttribute((const void*)k_phase<5>, hipFuncAttributeMaxDynamicSharedMemorySize, LDS_BYTES);
        (void)hipFuncSetAttribute((const void*)k_phase<6>, hipFuncAttributeMaxDynamicSharedMemorySize, LDS_BYTES);
        (void)hipFuncSetAttribute((const void*)k_phase<7>, hipFuncAttributeMaxDynamicSharedMemorySize, LDS_BYTES);
        (void)hipFuncSetAttribute((const void*)k_phase<8>, hipFuncAttributeMaxDynamicSharedMemorySize, LDS_BYTES);
        (void)hipFuncSetAttribute((const void*)k_phase<9>, hipFuncAttributeMaxDynamicSharedMemorySize, LDS_BYTES);
        (void)hipFuncSetAttribute((const void*)k_phase<10>, hipFuncAttributeMaxDynamicSharedMemorySize, LDS_BYTES);
        (void)hipOccupancyMaxActiveBlocksPerMultiprocessor(&per_cu, k_phase<5>, NTHREADS, LDS_BYTES);
#else
        (void)hipOccupancyMaxActiveBlocksPerMultiprocessor(&per_cu, mega, NTHREADS, LDS_BYTES);
#endif
        grid = cus * (per_cu < 1 ? per_cu : 1);
        if (grid <= 0) grid = cus;
    }
#define LAUNCH_PH(PT, l) hipLaunchKernelGGL(k_phase<PT>, dim3(grid), dim3(NTHREADS), LDS_BYTES, stream, p, l)
#if MK_LAUNCHES == 1
#define LAUNCH_MEGA() hipLaunchKernelGGL(mega, dim3(grid), dim3(NTHREADS), LDS_BYTES, stream, p)
#else
#define LAUNCH_MEGA() do {} while (0)
#endif
    const int hi = 1000;
#endif
#if MK_LAUNCHES == 1
    (void)hi; LAUNCH_MEGA();
#else
    {
        int ph = 0;
#define STEP(PT, l) do { if (ph++ < hi) LAUNCH_PH(PT, l); } while (0)
        STEP(0, 0);
        for (int l = 0; l < DEPTH; ++l) { STEP(1, l); STEP(2, l); STEP(5, l); STEP(6, l); STEP(7, l); STEP(8, l); STEP(9, l); }
        STEP(10, 0);
    }
#endif
}

#ifdef EMU
#include <string>
static void dump_file(const std::string& path, const void* ptr, size_t bytes) { FILE* f = fopen(path.c_str(), "wb"); fwrite(ptr, 1, bytes, f); fclose(f); }
extern "C" void emu_debug_dump(void* d_ws, const char* dir) {
    char* ws = (char*)d_ws; std::string d(dir);
    dump_file(d + "/ws_X.bin", ws + OFF_X, (size_t)NT * D * 4);
    dump_file(d + "/ws_H.bin", ws + OFF_H, (size_t)NT * D * 2);
    dump_file(d + "/ws_P.bin", ws + OFF_P, (size_t)NT * PW * 2);
    dump_file(d + "/ws_MIX.bin", ws + OFF_MIX, (size_t)NT * MIXW * 2);
    dump_file(d + "/ws_MOD.bin", ws + OFF_MOD, (size_t)DEPTH * (NB + 1) * 6 * D * 4);
    dump_file(d + "/ws_ROUTE.bin", ws + OFF_ROUTE, (size_t)NT * 32);
}
#endif
```

```cpp
#ifndef EMU
#include <hip/hip_runtime.h>
#endif
#include <stdint.h>
#include <stddef.h>
#include <math.h>

#ifdef EMU
#include <chrono>
#ifndef E_D
#define E_D 256
#define E_B 2
#define E_S 1024
#define E_DEPTH 2
#define E_L 128
#define E_EH 256
#endif
constexpr int D = E_D, NB = E_B, S = E_S, DEPTH = E_DEPTH, L = E_L, EH = E_EH;
#else
constexpr int D = 1024, NB = 8, S = 4096, DEPTH = 4, L = 256, EH = 512;
#endif
constexpr int NL = NB * S, NC = NB * L, NT = NL + NC;
constexpr int IMG_ROWS = S / 64;
constexpr int PW = 3104;
constexpr int C_QA = 0, C_KA = 512, C_VA = 1024, C_QB = 1536, C_KB = 1664, C_VB = 1792, C_RB = 2048, C_GB = 2304, C_QN = 2336, C_KN = 2592, C_VN = 2848;
constexpr int MIXW = 1024;
constexpr int NEXP = 32;
constexpr int LC = L / 64, SC = S / 64, NCH = LC + SC;
constexpr int NTHREADS = 512;
constexpr float LOG2E = 1.4426950408889634f;
constexpr float NORM_EPS = 1e-6f;
constexpr int YROWS = 2 * NT + NEXP * 256;

typedef unsigned short bf16_t;
typedef short bf16x8 __attribute__((ext_vector_type(8)));
typedef short bf16x4 __attribute__((ext_vector_type(4)));
typedef float f32x4 __attribute__((ext_vector_type(4)));
typedef float f32x16 __attribute__((ext_vector_type(16)));
typedef unsigned u32x4 __attribute__((ext_vector_type(4)));
typedef unsigned u32x2 __attribute__((ext_vector_type(2)));

#ifdef EMU
#define MFMA32(a, b, c) emu_mfma32(a, b, c)
#define MFMA16(a, b, c) emu_mfma16(a, b, c)
#define MFMA16F32(a, b, c) emu_mfma16f32(a, b, c)
#define WAVE_SYNC() ((void)__ballot(1))
#define DYN_LDS(name) char* name = emu::dyn_lds()
#define EXP2F(x) exp2f(x)
#else
#define MFMA32(a, b, c) __builtin_amdgcn_mfma_f32_32x32x16_bf16(a, b, c, 0, 0, 0)
#define MFMA16(a, b, c) __builtin_amdgcn_mfma_f32_16x16x32_bf16(a, b, c, 0, 0, 0)
#define MFMA16F32(a, b, c) __builtin_amdgcn_mfma_f32_16x16x4f32(a, b, c, 0, 0, 0)
#define WAVE_SYNC() __builtin_amdgcn_wave_barrier()
#define DYN_LDS(name) extern __shared__ __attribute__((aligned(16))) char name[]
#define EXP2F(x) __builtin_amdgcn_exp2f(x)
#endif

#ifdef EMU
#define LAUNDER_S(x) do {} while (0)
#define LAUNDER_GPTR(x) do {} while (0)
#else
#define LAUNDER_S(x) asm volatile("" : "+s"(x))
#define LAUNDER_GPTR(x) do { unsigned long long _v = (unsigned long long)(x); asm volatile("" : "+s"(_v)); (x) = (decltype(x))(__attribute__((address_space(1))) char*)_v; } while (0)
#endif

#ifdef EMU
__device__ __forceinline__ int TID() { return (int)threadIdx.x; }
__device__ __forceinline__ int BID() { return (int)blockIdx.x; }
__device__ __forceinline__ int GDIM() { return (int)gridDim.x; }
#else
__device__ __forceinline__ int TID() { int t = (int)threadIdx.x; asm volatile("" : "+v"(t)); return t; }
__device__ __forceinline__ int BID() { int t = (int)blockIdx.x; asm volatile("" : "+s"(t)); return t; }
__device__ __forceinline__ int GDIM() { int t = (int)gridDim.x; asm volatile("" : "+s"(t)); return t; }
#endif
__device__ __forceinline__ unsigned f2u(float f) { return __builtin_bit_cast(unsigned, f); }
__device__ __forceinline__ float u2f(unsigned u) { return __builtin_bit_cast(float, u); }
__device__ __forceinline__ bf16_t f2bf(float f) { unsigned u = f2u(f); u += 0x7fffu + ((u >> 16) & 1u); return (bf16_t)(u >> 16); }
__device__ __forceinline__ float bf2f(bf16_t h) { return u2f((unsigned)h << 16); }
#ifdef EMU
__device__ __forceinline__ unsigned pack2(float lo, float hi) { return (unsigned)f2bf(lo) | ((unsigned)f2bf(hi) << 16); }
#else
typedef float pk_f2 __attribute__((ext_vector_type(2)));
typedef __bf16 pk_b2 __attribute__((ext_vector_type(2)));
__device__ __forceinline__ unsigned pack2(float lo, float hi) { const pk_f2 v = {lo, hi}; return __builtin_bit_cast(unsigned, __builtin_convertvector(v, pk_b2)); }
#endif
#ifdef EMU
#define LOG2F_FAST(x) log2f(x)
#define RCPF_FAST(x) (1.0f / (x))
#else
#define LOG2F_FAST(x) __builtin_amdgcn_logf(x)
#define RCPF_FAST(x) __builtin_amdgcn_rcpf(x)
#endif
__device__ __forceinline__ float siluf(float x) { return x / (1.0f + expf(-x)); }
__device__ __forceinline__ float exp_fast(float x) { return EXP2F(x * LOG2E); }
__device__ __forceinline__ float silu_fast(float x) { return x * RCPF_FAST(1.0f + EXP2F(-x * LOG2E)); }
__device__ __forceinline__ float log_sigmoid_fast(float x) { return fminf(x, 0.f) - 0.6931471805599453f * LOG2F_FAST(1.0f + EXP2F(-fabsf(x) * LOG2E)); }
__device__ __forceinline__ float log_sigmoidf(float x) { return fminf(x, 0.f) - log1pf(expf(-fabsf(x))); }

#ifdef EMU
__device__ __forceinline__ float xhalf_max(float v) { return fmaxf(v, __shfl_xor(v, 32)); }
__device__ __forceinline__ float xhalf_sum(float v) { return v + __shfl_xor(v, 32); }
#else
__device__ __forceinline__ float xhalf_max(float v) { const auto r = __builtin_amdgcn_permlane32_swap(f2u(v), f2u(v), false, false); return fmaxf(u2f(r[0]), u2f(r[1])); }
__device__ __forceinline__ float xhalf_sum(float v) { const auto r = __builtin_amdgcn_permlane32_swap(f2u(v), f2u(v), false, false); return u2f(r[0]) + u2f(r[1]); }
#endif
__device__ __forceinline__ float wave_sum(float v) {
#pragma unroll
    for (int m = 32; m >= 1; m >>= 1) v += __shfl_xor(v, m);
    return v;
}

constexpr size_t al256(size_t x) { return (x + 255) & ~(size_t)255; }
constexpr size_t BAR_BYTES = 16384;
constexpr size_t OFF_BAR = 0;
constexpr size_t OFF_CNT = OFF_BAR + BAR_BYTES;
constexpr size_t ZERO_BYTES = OFF_CNT + 4096;
constexpr size_t OFF_ROPE = ZERO_BYTES;
constexpr size_t OFF_MOD = OFF_ROPE + 8192;
constexpr size_t OFF_WIN = al256(OFF_MOD + (size_t)DEPTH * 9 * 6 * D * 4);
constexpr size_t OFF_WOUT = al256(OFF_WIN + (size_t)DEPTH * 3328 * D * 2);
constexpr size_t OFF_WUP = al256(OFF_WOUT + (size_t)DEPTH * D * MIXW * 2);
constexpr size_t OFF_WDN = al256(OFF_WUP + (size_t)DEPTH * NEXP * 2 * EH * D * 2);
constexpr size_t OFF_X = al256(OFF_WDN + (size_t)DEPTH * NEXP * D * EH * 2);
constexpr size_t OFF_H = al256(OFF_X + (size_t)NT * D * 4);
constexpr size_t OFF_P = al256(OFF_H + (size_t)NT * D * 2);
constexpr size_t OFF_MIX = al256(OFF_P + (size_t)NT * PW * 2);
constexpr size_t OFF_GKV = al256(OFF_MIX + (size_t)NT * MIXW * 2);
constexpr size_t OFF_GDEC = al256(OFF_GKV + (size_t)NB * 4 * 2 * NCH * 4096 * 4);
constexpr size_t OFF_ROUTE = al256(OFF_GDEC + (size_t)NB * 4 * 2 * NCH * 32 * 4);
constexpr size_t OFF_LIST = al256(OFF_ROUTE + (size_t)NT * 32);
constexpr size_t OFF_ACT = al256(OFF_LIST + (size_t)NEXP * NT * 4);
constexpr size_t OFF_Y = al256(OFF_ACT + (size_t)YROWS * EH * 2);
constexpr size_t OFF_S_G1 = al256(OFF_Y + (size_t)YROWS * D * 2); constexpr size_t N_S_G1 = (size_t)(DEPTH * D);
constexpr size_t OFF_S_G2 = al256(OFF_S_G1 + N_S_G1 * 4); constexpr size_t N_S_G2 = (size_t)(DEPTH * D);
constexpr size_t OFF_S_LAM = al256(OFF_S_G2 + N_S_G2 * 4); constexpr size_t N_S_LAM = (size_t)(DEPTH * 256);
constexpr size_t OFF_S_GSUB = al256(OFF_S_LAM + N_S_LAM * 4); constexpr size_t N_S_GSUB = (size_t)(DEPTH * 128);
constexpr size_t OFF_S_WDEC = al256(OFF_S_GSUB + N_S_GSUB * 4); constexpr size_t N_S_WDEC = (size_t)(DEPTH * 2 * 16 * 128);
constexpr size_t OFF_S_BDEC = al256(OFF_S_WDEC + N_S_WDEC * 4); constexpr size_t N_S_BDEC = (size_t)(DEPTH * 2 * 128);
constexpr size_t OFF_S_GGLA = al256(OFF_S_BDEC + N_S_BDEC * 4); constexpr size_t N_S_GGLA = (size_t)(DEPTH * 64);
constexpr size_t OFF_S_RPB = al256(OFF_S_GGLA + N_S_GGLA * 4); constexpr size_t N_S_RPB = (size_t)(DEPTH * 4 * 15 * 31);
constexpr size_t OFF_S_WRG = al256(OFF_S_RPB + N_S_RPB * 4); constexpr size_t N_S_WRG = (size_t)(DEPTH * D * 4);
constexpr size_t OFF_S_BRG = al256(OFF_S_WRG + N_S_WRG * 4); constexpr size_t N_S_BRG = (size_t)(DEPTH * 4);
constexpr size_t OFF_S_WRE = al256(OFF_S_BRG + N_S_BRG * 4); constexpr size_t N_S_WRE = (size_t)(DEPTH * D * 32);
constexpr size_t OFF_S_BRE = al256(OFF_S_WRE + N_S_WRE * 4); constexpr size_t N_S_BRE = (size_t)(DEPTH * 32);
constexpr size_t OFF_S_GFIN = al256(OFF_S_BRE + N_S_BRE * 4); constexpr size_t N_S_GFIN = (size_t)(D);
constexpr size_t OFF_WRT = al256(OFF_S_GFIN + N_S_GFIN * 4);
constexpr size_t OFF_XD = al256(OFF_WRT + (size_t)DEPTH * 48 * D * 4);
constexpr size_t WS_TOTAL = al256(OFF_XD + (size_t)NT * D * 2);

struct PP {
    char* ws; float* out; const float* x; const float* ctx;
    __device__ __forceinline__ const float* sm(size_t off) const { return (const float*)(ws + off); }
};
struct Params {
    const float* x; const float* c; const float* ctx; const float* c_ctx; const float* w_mod; const float* b_mod;
    const float* g1; const float* g2; const float* w_in; const float* w_out; const float* lam; const float* g_sub;
    const float* w_dec; const float* b_dec; const float* g_gla; const float* rpb; const float* w_rg; const float* b_rg;
    const float* w_re; const float* b_re; const float* w_up; const float* w_dn; const float* g_fin;
    float* out; char* ws;
};

#ifdef EMU
struct GridBar { unsigned* ctr; };
__device__ __forceinline__ void grid_barrier(GridBar& gb) { __shared__ unsigned gen; emu_grid_barrier(gb.ctr, gen); }
#else
#define XB_TMO      128
#define XB_XCNT(j)  (256  + 64 * (j))
#define XB_XSUB(j)  (1280 + 64 * (j))
#define XB_XGEN(j)  (2304 + 64 * (j))
#define XB_TOP      3328
#define XB_TOPGEN   3392
#define XCD_BAR_WORDS 3456
#define XB_SPIN_CAP (1u << 22)
#define LAS __attribute__((address_space(3)))
__device__ __forceinline__ unsigned xb_ld(unsigned* p)              { return __hip_atomic_load(p, __ATOMIC_RELAXED, __HIP_MEMORY_SCOPE_AGENT); }
__device__ __forceinline__ unsigned xb_add(unsigned* p, unsigned v) { return __hip_atomic_fetch_add(p, v, __ATOMIC_RELAXED, __HIP_MEMORY_SCOPE_AGENT); }
__device__ __forceinline__ unsigned xb_xcc_id() { return (unsigned)__builtin_amdgcn_s_getreg((3 << 11) | 20) & 0xFu; }
#define XB_SPIN(cond, bar) do { unsigned _sp = 0; while (cond) { __builtin_amdgcn_s_sleep(1); \
    if ((++_sp & 255u) == 0u) { if (xb_ld(&(bar)[XB_TMO])) break; if (_sp > XB_SPIN_CAP) { atomicAdd(&(bar)[XB_TMO], 1u); break; } } } } while (0)
struct XcdBarrier { unsigned* bar; unsigned x; volatile LAS unsigned* st; };
__device__ __forceinline__ XcdBarrier xcd_barrier_post(unsigned* bar, volatile LAS unsigned* st) {
    XcdBarrier b; b.bar = bar; b.x = xb_xcc_id(); b.st = st;
    if (threadIdx.x == 0) (void)xb_add(&bar[XB_XCNT(b.x)], 1u);
    return b;
}
__device__ __forceinline__ void xcd_barrier_complete(unsigned* bar, unsigned x, unsigned& nloc, unsigned& nx) {
    const unsigned G = gridDim.x * gridDim.y * gridDim.z;
    unsigned sum, cnt, mine, sp = 0u;
    for (;;) {
        sum = 0u; cnt = 0u; mine = 0u;
#pragma unroll
        for (unsigned j = 0; j < 16; ++j) { const unsigned c = xb_ld(&bar[XB_XCNT(j)]); sum += c; cnt += (c > 0u) ? 1u : 0u; mine = (j == x) ? c : mine; }
        if (sum == G) break;
        __builtin_amdgcn_s_sleep(1);
        if ((++sp & 255u) == 0u) { if (xb_ld(&bar[XB_TMO])) break; if (sp > XB_SPIN_CAP) { atomicAdd(&bar[XB_TMO], 1u); break; } }
    }
    nloc = mine > 0u ? mine : 1u; nx = cnt > 0u ? cnt : 1u;
}
__device__ __forceinline__ void xcd_barrier(const XcdBarrier& b) {
    asm volatile("s_waitcnt vmcnt(0)" ::: "memory");
    __syncthreads();
    if (threadIdx.x == 0) {
        unsigned* bar = b.bar;
        __builtin_amdgcn_s_waitcnt(0);
        unsigned nloc = b.st[0], nx = b.st[1];
        if (nloc == 0u) { xcd_barrier_complete(bar, b.x, nloc, nx); b.st[0] = nloc; b.st[1] = nx; }
        const unsigned old = xb_add(&bar[XB_XSUB(b.x)], 1u);
        const unsigned gen = old / nloc;
        if (old + 1u == (gen + 1u) * nloc) {
            __builtin_amdgcn_fence(__ATOMIC_RELEASE, "agent");
            asm volatile("s_waitcnt vmcnt(0)" ::: "memory");
            const unsigned og = xb_add(&bar[XB_TOP], 1u);
            const unsigned tg = og / nx;
            if (og + 1u == (tg + 1u) * nx) xb_add(&bar[XB_TOPGEN], 1u);
            else XB_SPIN(xb_ld(&bar[XB_TOPGEN]) == tg, bar);
            __builtin_amdgcn_fence(__ATOMIC_ACQUIRE, "agent");
            xb_add(&bar[XB_XGEN(b.x)], 1u);
            asm volatile("s_waitcnt vmcnt(0)" ::: "memory");
        } else {
            XB_SPIN(xb_ld(&bar[XB_XGEN(b.x)]) == gen, bar);
            __builtin_amdgcn_fence(__ATOMIC_ACQUIRE, "agent");
            asm volatile("s_waitcnt vmcnt(0)" ::: "memory");
        }
    }
    __syncthreads();
}
typedef XcdBarrier GridBar;
__device__ __forceinline__ void grid_barrier(GridBar& gb) {
    XcdBarrier b = gb;
    asm volatile("" : "+s"(b.x));
    xcd_barrier(b);
}
#endif

struct CvtDesc { const float* src; bf16_t* dst; int K, N, perm; };
__device__ __forceinline__ int up_perm(int n) { const int j = n < EH ? n : n - EH; return (j >> 4) * 32 + (n < EH ? 0 : 16) + (j & 15); }

__device__ __forceinline__ void cvt_load(const CvtDesc& d, int tk, int tn, f32x4 (&r)[4]) {
    const int tid = TID(), c4 = (tid & 15) * 4, n = tn * 64 + c4;
#pragma unroll
    for (int i = 0; i < 4; ++i) { const int k = tk * 128 + (tid >> 4) + 32 * i;
        r[i] = (n < d.N) ? *(const f32x4*)(d.src + (size_t)k * d.N + n) : (f32x4){0.f, 0.f, 0.f, 0.f}; }
}
__device__ __forceinline__ void cvt_store(const CvtDesc& d, int tk, int tn, const f32x4 (&r)[4], char* lds) {
    float* t = (float*)lds;
    const int tid = TID(), c4 = (tid & 15) * 4;
    __syncthreads();
#pragma unroll
    for (int i = 0; i < 4; ++i) { const int kk = (tid >> 4) + 32 * i;
#pragma unroll
        for (int j = 0; j < 4; ++j) t[kk * 65 + c4 + j] = r[i][j]; }
    __syncthreads();
#pragma unroll
    for (int j = 0; j < 2; ++j) {
        const int c = tid + j * NTHREADS, kc = c & 15, nn = c >> 4, n = tn * 64 + nn;
        if (n < d.N) {
            const int nd = d.perm ? up_perm(n) : n;
            u32x4 v;
            v[0] = pack2(t[(kc * 8 + 0) * 65 + nn], t[(kc * 8 + 1) * 65 + nn]);
            v[1] = pack2(t[(kc * 8 + 2) * 65 + nn], t[(kc * 8 + 3) * 65 + nn]);
            v[2] = pack2(t[(kc * 8 + 4) * 65 + nn], t[(kc * 8 + 5) * 65 + nn]);
            v[3] = pack2(t[(kc * 8 + 6) * 65 + nn], t[(kc * 8 + 7) * 65 + nn]);
            *(u32x4*)(d.dst + (size_t)nd * d.K + tk * 128 + kc * 8) = v;
        }
    }
}
__device__ __forceinline__ void cvt_decode(const Params& p, int it, CvtDesc& d, int& tk, int& tn) {
    constexpr int T_IN = (D / 128) * ((PW + 63) / 64), T_OUT = (MIXW / 128) * (D / 64), T_UP = (D / 128) * (2 * EH / 64), T_DN = (EH / 128) * (D / 64);
    constexpr int PER_LAYER = T_IN + T_OUT + NEXP * (T_UP + T_DN);
    const int l = it / PER_LAYER; int r = it % PER_LAYER;
    if (r < T_IN) { d.src = p.w_in + (size_t)l * D * PW; d.dst = (bf16_t*)(p.ws + OFF_WIN) + (size_t)l * 3328 * D; d.K = D; d.N = PW; d.perm = 0; }
    else if ((r -= T_IN) < T_OUT) { d.src = p.w_out + (size_t)l * MIXW * D; d.dst = (bf16_t*)(p.ws + OFF_WOUT) + (size_t)l * D * MIXW; d.K = MIXW; d.N = D; d.perm = 0; }
    else if ((r -= T_OUT) < NEXP * T_UP) { const int e = r / T_UP; r %= T_UP; d.src = p.w_up + ((size_t)l * NEXP + e) * D * 2 * EH; d.dst = (bf16_t*)(p.ws + OFF_WUP) + ((size_t)l * NEXP + e) * 2 * EH * D; d.K = D; d.N = 2 * EH; d.perm = 1; }
    else { r -= NEXP * T_UP; const int e = r / T_DN; r %= T_DN; d.src = p.w_dn + ((size_t)l * NEXP + e) * EH * D; d.dst = (bf16_t*)(p.ws + OFF_WDN) + ((size_t)l * NEXP + e) * D * EH; d.K = EH; d.N = D; d.perm = 0; }
    const int nkt = d.K / 128;
    tk = r % nkt; tn = r / nkt;
}
constexpr int CVT_PER_LAYER = (D / 128) * ((PW + 63) / 64) + (MIXW / 128) * (D / 64) + NEXP * ((D / 128) * (2 * EH / 64) + (EH / 128) * (D / 64));

constexpr int CVT_DENSE0 = (D / 128) * ((PW + 63) / 64) + (MIXW / 128) * (D / 64);
__device__ void phase_prologue(const Params& p, char* lds) {
    const int tid = TID(), bid = BID(), G = GDIM();
    if (bid == 0) {
        float* rope = (float*)(p.ws + OFF_ROPE);
        for (int e = tid; e < 64 * 16; e += NTHREADS) {
            const int pos = e >> 4, i = e & 15;
            const float inv = powf(10000.0f, -(float)i / 16.0f);
            const float ang = (float)pos * inv;
            rope[e * 2] = cosf(ang); rope[e * 2 + 1] = sinf(ang);
        }
    }
    {
        const size_t gt = (size_t)bid * NTHREADS + tid, gs = (size_t)G * NTHREADS;
#define SM_LIST(X) X(G1, p.g1) X(G2, p.g2) X(LAM, p.lam) X(GSUB, p.g_sub) X(WDEC, p.w_dec) X(BDEC, p.b_dec) X(GGLA, p.g_gla) X(RPB, p.rpb) X(WRG, p.w_rg) X(BRG, p.b_rg) \
        X(WRE, p.w_re) X(BRE, p.b_re) X(GFIN, p.g_fin)
#define SM_MAX(NAME, src) nmax = N_S_##NAME > nmax ? N_S_##NAME : nmax;
#define SM_LOAD(NAME, src) const float v_##NAME = e < N_S_##NAME ? (src)[e] : 0.f;
#define SM_STORE(NAME, src) if (e < N_S_##NAME) ((float*)(p.ws + OFF_S_##NAME))[e] = v_##NAME;
        size_t nmax = 0; SM_LIST(SM_MAX)
        for (size_t e = gt; e < nmax; e += gs) { SM_LIST(SM_LOAD) SM_LIST(SM_STORE) }
#undef SM_LIST
#undef SM_MAX
#undef SM_LOAD
#undef SM_STORE
        for (size_t e = gt; e < (size_t)DEPTH * 48 * D; e += gs) {
            const int j = (int)(e & 7), lane_ = (int)((e >> 3) & 63), sx = (int)((e >> 9) & 3), c = (int)((e >> 11) % (D / 128)), nb = (int)((e / ((size_t)2048 * (D / 128))) % 3), l = (int)(e / ((size_t)3 * 2048 * (D / 128)));
            const int n = nb * 16 + (lane_ & 15), k = 128 * c + 32 * sx + 8 * (lane_ >> 4) + j;
            const float w = n < 4 ? p.w_rg[((size_t)l * D + k) * 4 + n] : (n < 36 ? p.w_re[((size_t)l * D + k) * 32 + (n - 4)] : 0.f);
            const bf16_t hi = f2bf(w), lo = f2bf(w - bf2f(hi));
            bf16_t* dst = (bf16_t*)(p.ws + OFF_WRT) + (e >> 3) * 16;
            dst[j] = hi; dst[8 + j] = lo;
        }
    }
    {
        int it = bid; CvtDesc dc, dn; int tk = 0, tn = 0, tk2 = 0, tn2 = 0; f32x4 rc[4], rn[4];
        if (it < CVT_DENSE0) { cvt_decode(p, it, dc, tk, tn); cvt_load(dc, tk, tn, rc); }
        while (it < CVT_DENSE0) {
            const int nx = it + G;
            if (nx < CVT_DENSE0) { cvt_decode(p, nx, dn, tk2, tn2); cvt_load(dn, tk2, tn2, rn); }
            cvt_store(dc, tk, tn, rc, lds);
            it = nx; dc = dn; tk = tk2; tn = tn2;
#pragma unroll
            for (int i = 0; i < 4; ++i) rc[i] = rn[i];
        }
    }
    {
        float* cact = (float*)lds;
        float* red = cact + (NB + 1) * D;
        __syncthreads();
        for (int e = tid; e < (NB + 1) * D; e += NTHREADS) { const int r = e / D, k = e % D; const float v = r < NB ? p.c[r * D + k] : p.c_ctx[k]; cact[e] = siluf(v); }
        __syncthreads();
        constexpr int NBLK = 6 * D / 64;
        float* mod = (float*)(p.ws + OFF_MOD);
        for (int it = bid; it < DEPTH * NBLK; it += G) {
            const int l = it / NBLK, n0 = (it % NBLK) * 64, ks = tid >> 6, nn = tid & 63;
            float acc[NB + 1];
#pragma unroll
            for (int r = 0; r <= NB; ++r) acc[r] = 0.f;
            const float* w = p.w_mod + (size_t)l * D * 6 * D + n0 + nn;
            for (int k0 = ks * (D / 8); k0 < (ks + 1) * (D / 8); k0 += 8) {
                float wv[8];
#pragma unroll
                for (int j = 0; j < 8; ++j) wv[j] = w[(size_t)(k0 + j) * 6 * D];
#pragma unroll
                for (int j = 0; j < 8; ++j)
#pragma unroll
                    for (int r = 0; r <= NB; ++r) acc[r] += cact[r * D + k0 + j] * wv[j];
            }
#pragma unroll
            for (int r = 0; r <= NB; ++r) red[(ks * 64 + nn) * (NB + 1) + r] = acc[r];
            __syncthreads();
            for (int e = tid; e < 64 * (NB + 1); e += NTHREADS) {
                const int r = e / 64, n2 = e % 64; float s = 0.f;
#pragma unroll
                for (int q = 0; q < 8; ++q) s += red[(q * 64 + n2) * (NB + 1) + r];
                mod[((size_t)l * (NB + 1) + r) * 6 * D + n0 + n2] = s + p.b_mod[(size_t)l * 6 * D + n0 + n2];
            }
            __syncthreads();
        }
    }
}

constexpr int CVT_DENSE = (D / 128) * ((PW + 63) / 64) + (MIXW / 128) * (D / 64), CVT_EXPERT = CVT_PER_LAYER - CVT_DENSE;
static_assert(CVT_EXPERT % 8 == 0, "a batch must not straddle the two layers");
__device__ void cvt_ahead(const Params& p, int l, char* lds) {
    int* qi = (int*)(lds - 8);
    int* qc = (int*)(p.ws + OFF_CNT + 2048) + l * 64 + 5;
    constexpr int BATCH = 8, INFL = 8;
    const int total = (l < DEPTH - 1) ? CVT_PER_LAYER : CVT_EXPERT;
    for (;;) {
        __syncthreads();
        if (TID() == 0) *qi = atomicAdd(qc, 1);
        __syncthreads();
        const int b0 = *qi * BATCH;
        if (b0 >= total) break;
        const int n = (b0 + BATCH < total) ? BATCH : total - b0;
        const int it0 = (b0 < CVT_EXPERT) ? l * CVT_PER_LAYER + CVT_DENSE + b0 : (l + 1) * CVT_PER_LAYER + (b0 - CVT_EXPERT);
        CvtDesc ds[INFL]; int tk[INFL], tn[INFL]; f32x4 rr[INFL][4];
#pragma unroll
        for (int k = 0; k < INFL; ++k) if (k < n) { cvt_decode(p, it0 + k, ds[k], tk[k], tn[k]); cvt_load(ds[k], tk[k], tn[k], rr[k]); }
#pragma unroll
        for (int k = 0; k < BATCH; ++k) {
            if (k < n) {
                cvt_store(ds[k % INFL], tk[k % INFL], tn[k % INFL], rr[k % INFL], lds);
                if (k + INFL < n) { cvt_decode(p, it0 + k + INFL, ds[k % INFL], tk[k % INFL], tn[k % INFL]); cvt_load(ds[k % INFL], tk[k % INFL], tn[k % INFL], rr[k % INFL]); }
            }
        }
    }
}

__device__ __forceinline__ void load_pad_start(const PP& p, int layer, int* ps) {
    if (TID() == 0) {
        const int* cnt = (const int*)(p.ws + OFF_CNT) + layer * NEXP; int a = 0;
        for (int e = 0; e < NEXP; ++e) { ps[e] = a; a += (cnt[e] + 255) / 256 * 256; }
        ps[NEXP] = a;
    }
}
__device__ __forceinline__ int tok_batch(int t) { return t < NL ? t / S : NB; }

template <int MODE>
__device__ void phase_norm(const PP& p, int l, char* lds) {
    const int tid = TID(), lane = tid & 63, wave = tid >> 6, G = GDIM();
    int* ps = (int*)lds;
    float* X = (float*)(p.ws + OFF_X);
    bf16_t* H = (bf16_t*)(p.ws + OFF_H);
    const bf16_t* Y = (const bf16_t*)(p.ws + OFF_Y);
    const int* route = (const int*)(p.ws + OFF_ROUTE);
    const float* mod = (const float*)(p.ws + OFF_MOD);
    __syncthreads();
    const bool combine = (MODE == 0 && l > 0) || MODE == 2;
    const int lprev = MODE == 2 ? DEPTH - 1 : l - 1;
    if (combine) load_pad_start(p, lprev, ps);
    __syncthreads();
    const int ntok = (MODE == 2) ? NL : NT, stride = G * 8;
    constexpr int NV = D / 256;
    int t = BID() * 8 + wave;
    f32x4 xn[NV]; u32x4 rn0 = {0u, 0u, 0u, 0u}; u32x2 rn1 = {0u, 0u};
    const bool from_input = (MODE == 0) ? (l <= 1) : (DEPTH == 1);
    const bf16_t* XDb = (const bf16_t*)(p.ws + OFF_XD);
    u32x2 dn[NV];
#define NORM_XROW(t_) (from_input ? ((t_) < NL ? p.x + (size_t)(t_) * D : p.ctx + (size_t)((t_) - NL) * D) : X + (size_t)(t_) * D)
    if (t < ntok) {
        const float* xr = NORM_XROW(t);
#pragma unroll
        for (int i = 0; i < NV; ++i) xn[i] = *(const f32x4*)(xr + i * 256 + lane * 4);
        if (combine) { rn0 = *(const u32x4*)(route + (size_t)t * 8); rn1 = *(const u32x2*)(route + (size_t)t * 8 + 4);
#pragma unroll
            for (int i = 0; i < NV; ++i) dn[i] = *(const u32x2*)(XDb + (size_t)t * D + i * 256 + lane * 4); }
    }
    while (t < ntok) {
        const int mr = tok_batch(t), tn = t + stride;
        f32x4 xv[NV];
#pragma unroll
        for (int i = 0; i < NV; ++i) xv[i] = xn[i];
        if (combine) {
#pragma unroll
            for (int i = 0; i < NV; ++i) { xv[i][0] += u2f(dn[i][0] << 16); xv[i][1] += u2f(dn[i][0] & 0xffff0000u); xv[i][2] += u2f(dn[i][1] << 16); xv[i][3] += u2f(dn[i][1] & 0xffff0000u); }
        }
        u32x2 ya[NV], yb[NV]; f32x4 m5v[NV]; float g0 = 0.f, g1 = 0.f;
        if (combine) {
            const int e0 = (int)rn0[0], e1 = (int)rn0[1], s0 = (int)rn0[2], s1 = (int)rn0[3];
            g0 = u2f(rn1[0]); g1 = u2f(rn1[1]);
            const bf16_t* y0 = Y + (size_t)(ps[e0] + s0) * D; const bf16_t* y1 = Y + (size_t)(ps[e1] + s1) * D;
            const float* m5 = mod + ((size_t)lprev * (NB + 1) + mr) * 6 * D + 5 * D;
#pragma unroll
            for (int i = 0; i < NV; ++i) { ya[i] = *(const u32x2*)(y0 + i * 256 + lane * 4); yb[i] = *(const u32x2*)(y1 + i * 256 + lane * 4); m5v[i] = *(const f32x4*)(m5 + i * 256 + lane * 4); }
        }
        f32x4 gv[NV], shv[NV], scv[NV];
        if (MODE == 0) {
            const float* gg = p.sm(OFF_S_G1) + (size_t)l * D; const float* mrow = mod + ((size_t)l * (NB + 1) + mr) * 6 * D;
#pragma unroll
            for (int i = 0; i < NV; ++i) { gv[i] = *(const f32x4*)(gg + i * 256 + lane * 4); shv[i] = *(const f32x4*)(mrow + i * 256 + lane * 4); scv[i] = *(const f32x4*)(mrow + D + i * 256 + lane * 4); }
        } else {
#pragma unroll
            for (int i = 0; i < NV; ++i) gv[i] = *(const f32x4*)(p.sm(OFF_S_GFIN) + i * 256 + lane * 4);
        }
        if (tn < ntok) {
            const float* xr = NORM_XROW(tn);
#pragma unroll
            for (int i = 0; i < NV; ++i) xn[i] = *(const f32x4*)(xr + i * 256 + lane * 4);
            if (combine) { rn0 = *(const u32x4*)(route + (size_t)tn * 8); rn1 = *(const u32x2*)(route + (size_t)tn * 8 + 4);
#pragma unroll
                for (int i = 0; i < NV; ++i) dn[i] = *(const u32x2*)(XDb + (size_t)tn * D + i * 256 + lane * 4); }
        }
        if (combine) {
#pragma unroll
            for (int i = 0; i < NV; ++i) {
                xv[i][0] += m5v[i][0] * (g0 * u2f(ya[i][0] << 16) + g1 * u2f(yb[i][0] << 16));
                xv[i][1] += m5v[i][1] * (g0 * u2f(ya[i][0] & 0xffff0000u) + g1 * u2f(yb[i][0] & 0xffff0000u));
                xv[i][2] += m5v[i][2] * (g0 * u2f(ya[i][1] << 16) + g1 * u2f(yb[i][1] << 16));
                xv[i][3] += m5v[i][3] * (g0 * u2f(ya[i][1] & 0xffff0000u) + g1 * u2f(yb[i][1] & 0xffff0000u));
            }
        }
        if (MODE == 0 && l > 0) {
#pragma unroll
            for (int i = 0; i < NV; ++i) *(f32x4*)(X + (size_t)t * D + i * 256 + lane * 4) = xv[i];
        }
        float ss = 0.f;
#pragma unroll
        for (int i = 0; i < NV; ++i) ss += xv[i][0] * xv[i][0] + xv[i][1] * xv[i][1] + xv[i][2] * xv[i][2] + xv[i][3] * xv[i][3];
        ss = wave_sum(ss);
        const float rstd = 1.0f / sqrtf(ss / (float)D + NORM_EPS);
        if (MODE == 2) {
#pragma unroll
            for (int i = 0; i < NV; ++i) { f32x4 v = {xv[i][0] * rstd * gv[i][0], xv[i][1] * rstd * gv[i][1], xv[i][2] * rstd * gv[i][2], xv[i][3] * rstd * gv[i][3]};
                *(f32x4*)(p.out + (size_t)t * D + i * 256 + lane * 4) = v; }
        } else {
#pragma unroll
            for (int i = 0; i < NV; ++i) {
                float hv[4];
#pragma unroll
                for (int j = 0; j < 4; ++j) hv[j] = xv[i][j] * rstd * gv[i][j] * (1.0f + scv[i][j]) + shv[i][j];
                u32x2 o; o[0] = pack2(hv[0], hv[1]); o[1] = pack2(hv[2], hv[3]);
                *(u32x2*)(H + (size_t)t * D + i * 256 + lane * 4) = o;
            }
        }
        t = tn;
    }
#undef NORM_XROW
}

constexpr int RXT = (NC * 16) / NL, RRT = 16 + RXT;
static_assert((NC * 16) % NL == 0 && RXT >= 1 && RXT <= 8, "context tokens must split evenly over the latent groups");
static_assert(D / 128 == 8, "one 128-column chunk per wave");
constexpr int RL_XS = 0, RL_VEC = RL_XS + RRT * D * 4, RL_RSV = RL_VEC + 4 * D * 4, RL_PLG = RL_RSV + 128 + RXT * 32, RL_LGS = RL_PLG + 8 * RRT * 48 * 4,
              RL_REC = RL_LGS + (RRT * 49 * 4 + 127) / 128 * 128, RL_HIST = RL_REC + 2048 * 16, RL_BIAS = RL_HIST + 256, ROUTER_LDS = RL_BIAS + 256;
__device__ void phase_router(const PP& p, int l, char* lds) {
    const int tid = TID(), lane = tid & 63, wave = tid >> 6, G = GDIM(), tt = lane & 15, q = lane >> 4;
    float* xs = (float*)(lds + RL_XS);
    float* gam = (float*)(lds + RL_VEC); float* shl = gam + D; float* gamx = shl + D; float* shx = gamx + D;
    float* rsv = (float*)(lds + RL_RSV);
    float* rsp = (float*)(lds + RL_RSV + 128);
    float* plg = (float*)(lds + RL_PLG);
    float* lgs = (float*)(lds + RL_LGS);
    int* recs = (int*)(lds + RL_REC);
    int* hist = (int*)(lds + RL_HIST); int* base = hist + NEXP;
    float* rbias = (float*)(lds + RL_BIAS);
    float* X = (float*)(p.ws + OFF_X);
    bf16_t* H = (bf16_t*)(p.ws + OFF_H);
    const bf16_t* XDb = (const bf16_t*)(p.ws + OFF_XD);
    const float* mod = (const float*)(p.ws + OFF_MOD);
    const float* gg = p.sm(OFF_S_G2) + (size_t)l * D;
    const int xt = (l == DEPTH - 1) ? 0 : RXT;
    const int ngr = NL / 16, nrows = 16 + xt;
    const int ngb = (ngr + G - 1) / G;
    constexpr int NV = D / 256;
    __syncthreads();
    bf16x8 wr[4][3][2];
    {
        const bf16_t* wp = (const bf16_t*)((const float*)(p.ws + OFF_WRT) + (size_t)l * 48 * D) + ((size_t)wave * 4) * 1024 + lane * 16;
#pragma unroll
        for (int ks = 0; ks < 4; ++ks)
#pragma unroll
            for (int nb = 0; nb < 3; ++nb) { const bf16_t* w_ = wp + (size_t)nb * (D / 128) * 4096 + ks * 1024; wr[ks][nb][0] = *(const bf16x8*)w_; wr[ks][nb][1] = *(const bf16x8*)(w_ + 8); }
    }
    if (tid < 36) rbias[tid] = tid < 4 ? p.sm(OFF_S_BRG)[l * 4 + tid] : p.sm(OFF_S_BRE)[l * 32 + tid - 4];
    if (xt > 0) {
        const float* mrowx = mod + ((size_t)l * (NB + 1) + NB) * 6 * D;
        for (int k = tid; k < D; k += NTHREADS) { gamx[k] = gg[k] * (1.0f + mrowx[4 * D + k]); shx[k] = mrowx[3 * D + k]; }
    }
#define R_TOK(g_, r_) ((r_) < 16 ? (g_) * 16 + (r_) : NL + (g_) * RXT + ((r_) - 16))
#define R_SRC(g_, r_) ((l == 0) ? ((r_) < 16 ? p.x + (size_t)((g_) * 16 + (r_)) * D : p.ctx + (size_t)((g_) * RXT + ((r_) - 16)) * D) : X + (size_t)R_TOK(g_, r_) * D)
    static_assert(D == 2 * NTHREADS || D < 2 * NTHREADS, "extra rows: two columns per thread");
    f32x4 pv[2][NV]; u32x2 pd[2][NV]; float pxa[RXT], pxb[RXT]; unsigned pxd[RXT]; float psc[D / NTHREADS], psh[D / NTHREADS];
    static_assert(D % NTHREADS == 0, "modulation vectors: D / 512 columns per thread");
#define R_FETCH(g_) do { _Pragma("unroll") for (int i = 0; i < 2; ++i) { const int r_ = wave + 8 * i; const float* xs_ = R_SRC(g_, r_); const bf16_t* dr_ = XDb + (size_t)R_TOK(g_, r_) * D; \
        _Pragma("unroll") for (int j = 0; j < NV; ++j) { pv[i][j] = *(const f32x4*)(xs_ + j * 256 + lane * 4); pd[i][j] = *(const u32x2*)(dr_ + j * 256 + lane * 4); } } \
        if (xt > 0 && 2 * tid < D) { _Pragma("unroll") for (int e_ = 0; e_ < RXT; ++e_) { const float* xs_ = R_SRC(g_, 16 + e_); pxa[e_] = xs_[2 * tid]; pxb[e_] = xs_[2 * tid + 1]; \
            pxd[e_] = *(const unsigned*)(XDb + (size_t)R_TOK(g_, 16 + e_) * D + 2 * tid); } } \
        { const float* mr_ = mod + ((size_t)l * (NB + 1) + tok_batch((g_) * 16)) * 6 * D; _Pragma("unroll") for (int j = 0; j < D / NTHREADS; ++j) { psc[j] = mr_[4 * D + tid + j * NTHREADS]; psh[j] = mr_[3 * D + tid + j * NTHREADS]; } } } while (0)
    float ggk[D / NTHREADS];
#pragma unroll
    for (int j = 0; j < D / NTHREADS; ++j) ggk[j] = gg[tid + j * NTHREADS];
    int g = BID();
    if (g < ngr) R_FETCH(g);
    int gi = 0;
    for (; g < ngr; g += G, ++gi) {
        const int tid = TID(), lane = tid & 63, wave = tid >> 6, tt = lane & 15, q = lane >> 4;
        const int t0 = g * 16;
#pragma unroll
        for (int i = 0; i < 2; ++i) {
            const int r = wave + 8 * i;
            {
                float ss = 0.f;
#pragma unroll
                for (int j = 0; j < NV; ++j) {
                    f32x4 v = pv[i][j]; const u32x2 dv = pd[i][j];
                    v[0] += u2f(dv[0] << 16); v[1] += u2f(dv[0] & 0xffff0000u); v[2] += u2f(dv[1] << 16); v[3] += u2f(dv[1] & 0xffff0000u);
                    *(f32x4*)(xs + r * D + j * 256 + lane * 4) = v;
                    ss += v[0] * v[0] + v[1] * v[1] + v[2] * v[2] + v[3] * v[3];
                }
                ss = wave_sum(ss);
                if (lane == 0) rsv[r] = 1.0f / sqrtf(ss / (float)D + NORM_EPS);
            }
        }
        if (xt > 0) {
#pragma unroll
            for (int e = 0; e < RXT; ++e) {
                float ss = 0.f;
                if (2 * tid < D) {
                    const float a = pxa[e] + u2f(pxd[e] << 16), b2 = pxb[e] + u2f(pxd[e] & 0xffff0000u);
                    xs[(16 + e) * D + 2 * tid] = a; xs[(16 + e) * D + 2 * tid + 1] = b2;
                    ss = a * a + b2 * b2;
                }
                ss = wave_sum(ss);
                if (lane == 0) rsp[e * 8 + wave] = ss;
            }
        }
#pragma unroll
        for (int j = 0; j < D / NTHREADS; ++j) { const int k = tid + j * NTHREADS; gam[k] = ggk[j] * (1.0f + psc[j]); shl[k] = psh[j]; }
        __syncthreads();
        if (g + G < ngr) R_FETCH(g + G);
#define R_H2(xrow_, gm_, sh_, rs_, hi_, lo_) do { const f32x4 x0 = *(const f32x4*)((xrow_) + k0), x1 = *(const f32x4*)((xrow_) + k0 + 4); \
                const f32x4 g0 = *(const f32x4*)((gm_) + k0), g1 = *(const f32x4*)((gm_) + k0 + 4), s0 = *(const f32x4*)((sh_) + k0), s1 = *(const f32x4*)((sh_) + k0 + 4); \
                float hv[8]; _Pragma("unroll") for (int e = 0; e < 4; ++e) { hv[e] = x0[e] * (rs_) * g0[e] + s0[e]; hv[4 + e] = x1[e] * (rs_) * g1[e] + s1[e]; } \
                u32x4 h_, l_; _Pragma("unroll") for (int e = 0; e < 4; ++e) { h_[e] = pack2(hv[2 * e], hv[2 * e + 1]); l_[e] = pack2(hv[2 * e] - u2f(h_[e] << 16), hv[2 * e + 1] - u2f(h_[e] & 0xffff0000u)); } \
                hi_ = h_; lo_ = l_; } while (0)
        {
            f32x4 acc[3];
#pragma unroll
            for (int nb = 0; nb < 3; ++nb) acc[nb] = (f32x4){0.f, 0.f, 0.f, 0.f};
            const float rs = rsv[tt];
#pragma unroll
            for (int ks = 0; ks < 4; ++ks) {
                const int k0 = 128 * wave + 32 * ks + 8 * q;
                u32x4 hi, lo;
                R_H2(xs + tt * D, gam, shl, rs, hi, lo);
                *(u32x4*)(H + (size_t)(t0 + tt) * D + k0) = hi;
                const bf16x8 ah = __builtin_bit_cast(bf16x8, hi), al = __builtin_bit_cast(bf16x8, lo);
#pragma unroll
                for (int nb = 0; nb < 3; ++nb) { acc[nb] = MFMA16(ah, wr[ks][nb][0], acc[nb]); acc[nb] = MFMA16(ah, wr[ks][nb][1], acc[nb]); acc[nb] = MFMA16(al, wr[ks][nb][0], acc[nb]); }
            }
#pragma unroll
            for (int nb = 0; nb < 3; ++nb)
#pragma unroll
                for (int r = 0; r < 4; ++r) plg[(wave * RRT + 4 * q + r) * 48 + nb * 16 + tt] = acc[nb][r];
        }
        if (xt > 0) {
            f32x4 acc[3];
#pragma unroll
            for (int nb = 0; nb < 3; ++nb) acc[nb] = (f32x4){0.f, 0.f, 0.f, 0.f};
            const int rx = 16 + (tt < RXT ? tt : 0);
            float sq = 0.f;
#pragma unroll
            for (int w = 0; w < 8; ++w) sq += rsp[(rx - 16) * 8 + w];
            const float rsx = 1.0f / sqrtf(sq / (float)D + NORM_EPS);
#pragma unroll
            for (int ks = 0; ks < 4; ++ks) {
                const int k0 = 128 * wave + 32 * ks + 8 * q;
                u32x4 hx, lx;
                R_H2(xs + rx * D, gamx, shx, rsx, hx, lx);
                if (tt < RXT) *(u32x4*)(H + (size_t)(NL + g * RXT + tt) * D + k0) = hx;
                const bf16x8 bh = __builtin_bit_cast(bf16x8, hx), bl = __builtin_bit_cast(bf16x8, lx);
#pragma unroll
                for (int nb = 0; nb < 3; ++nb) { acc[nb] = MFMA16(bh, wr[ks][nb][0], acc[nb]); acc[nb] = MFMA16(bh, wr[ks][nb][1], acc[nb]); acc[nb] = MFMA16(bl, wr[ks][nb][0], acc[nb]); }
            }
#pragma unroll
            for (int nb = 0; nb < 3; ++nb)
#pragma unroll
                for (int r = 0; r < 4; ++r) if (4 * q + r < RXT) plg[(wave * RRT + 16 + 4 * q + r) * 48 + nb * 16 + tt] = acc[nb][r];
        }
#undef R_H2
        __syncthreads();
        for (int e = tid; e < RRT * 48; e += NTHREADS) {
            float sacc = 0.f;
#pragma unroll
            for (int w = 0; w < 8; ++w) sacc += plg[w * RRT * 48 + e];
            lgs[(e / 48) * 49 + (e % 48)] = sacc;
        }
        __syncthreads();
        if (wave == 0 && lane < nrows) {
            const int tk = R_TOK(g, lane);
            float lg[4];
            int grp = 0; float gmax = -INFINITY;
#pragma unroll
            for (int o = 0; o < 4; ++o) { lg[o] = lgs[lane * 49 + o] + rbias[o]; if (lg[o] > gmax) { gmax = lg[o]; grp = o; } }
            float gs = 0.f;
#pragma unroll
            for (int o = 0; o < 4; ++o) gs += expf(lg[o] - gmax);
            const float pg = 1.0f / gs;
            float v0 = -INFINITY, v1 = -INFINITY; int i0 = 0, i1 = 0;
#pragma unroll
            for (int o = 0; o < 8; ++o) { const float v = lgs[lane * 49 + 4 + grp * 8 + o] + rbias[4 + grp * 8 + o];
                if (v > v0) { v1 = v0; i1 = i0; v0 = v; i0 = o; } else if (v > v1) { v1 = v; i1 = o; } }
            const float e1v = expf(v1 - v0), den = 1.0f / (1.0f + e1v);
            int* rec = recs + (gi * RRT + lane) * 4;
            rec[0] = tk; rec[1] = (grp * 8 + i0) | ((grp * 8 + i1) << 8); rec[2] = (int)f2u(den * pg); rec[3] = (int)f2u(e1v * den * pg);
        }
    }
#undef R_FETCH
#undef R_SRC
#undef R_TOK
    __syncthreads();
    if (tid < NEXP) hist[tid] = 0;
    __syncthreads();
    const int nrec = ngb * RRT;
    int myslot[4][2];
#define R_VALID(ri_) ({ const int gi_ = (ri_) / RRT, ln_ = (ri_) % RRT; (BID() + gi_ * G) < ngr && ln_ < nrows; })
#pragma unroll
    for (int k = 0; k < 4; ++k) {
        const int ri = tid + k * NTHREADS; myslot[k][0] = myslot[k][1] = 0;
        if (ri < nrec) { const int* rec = recs + ri * 4;
            if (R_VALID(ri)) { const int ee = rec[1]; myslot[k][0] = atomicAdd(&hist[ee & 255], 1); myslot[k][1] = atomicAdd(&hist[ee >> 8], 1); } }
    }
    __syncthreads();
    if (tid < NEXP) { const int c = hist[tid]; base[tid] = c ? atomicAdd((int*)(p.ws + OFF_CNT) + l * NEXP + tid, c) : 0; }
    __syncthreads();
#pragma unroll
    for (int k = 0; k < 4; ++k) {
        const int ri = tid + k * NTHREADS;
        if (ri < nrec) { const int* rec = recs + ri * 4;
            if (R_VALID(ri)) {
                const int tk = rec[0], e0 = rec[1] & 255, e1 = rec[1] >> 8, s0 = base[e0] + myslot[k][0], s1 = base[e1] + myslot[k][1];
                int* list = (int*)(p.ws + OFF_LIST);
                list[(size_t)e0 * NT + s0] = tk; list[(size_t)e1 * NT + s1] = tk;
                int* rt = (int*)(p.ws + OFF_ROUTE) + (size_t)tk * 8;
                rt[0] = e0; rt[1] = e1; rt[2] = s0; rt[3] = s1; rt[4] = rec[2]; rt[5] = rec[3];
            } }
    }
#undef R_VALID
}

#ifdef EMU
#define LAS3
__device__ __forceinline__ void emu_glds16(const void* g, void* l) { memcpy((char*)l + (threadIdx.x & 63) * 16, g, 16); }
#define GLDS16(gptr, ldsptr) emu_glds16((gptr), (ldsptr))
#define GLDS16_ASM(gptr, ldsptr) emu_glds16((gptr), (ldsptr))
#define WAIT_V(n) do {} while (0)
#define WAIT_L(n) do {} while (0)
#define S_BAR() __syncthreads()
#define SCHED_BAR() do {} while (0)
#define SETPRIO(x) do {} while (0)
#define READFIRSTLANE(x) (x)
#else
#define LAS3 __attribute__((address_space(3)))
#define GLDS16(gptr, ldsptr) __builtin_amdgcn_global_load_lds((const unsigned*)(gptr), (LAS3 unsigned*)(ldsptr), 16, 0, 0)
#define WAIT_V(n) asm volatile("s_waitcnt vmcnt(" #n ")" ::: "memory")
__device__ __forceinline__ void glds16_asm(const void* gsrc, unsigned lds_dst) {
    unsigned keep;
    asm volatile("s_mov_b32 %0, m0\n\ts_mov_b32 m0, %2\n\ts_nop 0\n\tglobal_load_lds_dwordx4 %1, off\n\ts_mov_b32 m0, %0" : "=&s"(keep) : "v"(gsrc), "s"(lds_dst) : "memory");
}
#define GLDS16_ASM(gptr, ldsptr) glds16_asm((gptr), (unsigned)(uintptr_t)(ldsptr))
#define WAIT_L(n) asm volatile("s_waitcnt lgkmcnt(" #n ")" ::: "memory")
#define S_BAR() __builtin_amdgcn_s_barrier()
#define SCHED_BAR() __builtin_amdgcn_sched_barrier(0)
#define SETPRIO(x) __builtin_amdgcn_s_setprio(x)
#define READFIRSTLANE(x) __builtin_amdgcn_readfirstlane(x)
#endif
namespace g8 {
constexpr int BM = 256, BK = 64, HALF = 128, HTB = HALF * BK * 2, STAGE_BYTES = 8 * HTB;
__device__ __forceinline__ int lds_byte(int r, int c) { const int st = (r >> 4) * 2 + (c >> 5), rr = r & 15, cc = c & 31, ob = rr * 64 + cc * 2; return st * 1024 + (ob ^ (((ob >> 9) & 1) << 5)); }
__device__ __forceinline__ void stage_rc(int b, int& R, int& C) { const int st = b / 1024, sb = b % 1024, swz = sb ^ (((sb >> 9) & 1) << 5); R = (st >> 1) * 16 + swz / 64; C = (st & 1) * 32 + (swz % 64) / 2; }
struct Unit { int pm, pn; const bf16_t* bt; int e; };
typedef f32x4 Acc[2][2][4][2];

template <class Sched, class Epi>
__device__ __forceinline__ void gemm_phase(char* lds_generic, const bf16_t* A, const int K, const Sched& S, const Epi& E) {
    LAS3 unsigned char* lds = (LAS3 unsigned char*)lds_generic;
    const int tid = TID(), wid = READFIRSTLANE(tid >> 6), lane = tid & 63, wr = wid >> 2, wc = wid & 3, fr = lane & 15, fq = lane >> 4;
    const int nt = K / BK;
    int sR[2], sC[2]; unsigned voffB[2];
#pragma unroll
    for (int i = 0; i < 2; ++i) { stage_rc(tid * 16 + i * 8192, sR[i], sC[i]); voffB[i] = (unsigned)(sR[i] * K + sC[i]) * 2u; }
    const size_t kstep = (size_t)(BK * 2);
    const size_t hstep = (size_t)HALF * K * 2;
    const unsigned ldsw = (unsigned)wid * 1024u;
    const int aoff = lds_byte(wr * 64 + fr, fq * 8), boff = lds_byte(wc * 32 + fr, fq * 8);
#define G8_SA(b, h) (((b) * 2 + (h)) * HTB)
#define G8_SB(b, h) ((4 + (b) * 2 + (h)) * HTB)
#define G8_STAGE(bufoff, gbase, voff) do { _Pragma("unroll") for (int _i = 0; _i < 2; ++_i) GLDS16((const char*)(gbase) + (voff)[_i], lds + (bufoff) + ldsw + _i * 8192); } while (0)
#define G8_LDA(dst, b, h) do { _Pragma("unroll") for (int m = 0; m < 4; ++m) _Pragma("unroll") for (int k = 0; k < 2; ++k) dst[m][k] = *(const LAS3 bf16x8*)(lds + G8_SA(b, h) + aoff + m * 2048 + k * 1024); } while (0)
#define G8_LDB(dst, b, h) do { _Pragma("unroll") for (int n = 0; n < 2; ++n) _Pragma("unroll") for (int k = 0; k < 2; ++k) dst[n][k] = *(const LAS3 bf16x8*)(lds + G8_SB(b, h) + boff + n * 2048 + k * 1024); } while (0)
#define G8_MMA(ai, bj, At, Bt) do { SETPRIO(1); _Pragma("unroll") for (int m = 0; m < 4; ++m) _Pragma("unroll") for (int n = 0; n < 2; ++n) _Pragma("unroll") for (int k = 0; k < 2; ++k) \
        acc[ai][bj][m][n] = MFMA16(Bt[n][k], At[m][k], acc[ai][bj][m][n]); SETPRIO(0); } while (0)
#define G8_VOFFA(dst, u) do { _Pragma("unroll") for (int _h = 0; _h < 2; ++_h) _Pragma("unroll") for (int _i = 0; _i < 2; ++_i) dst[_h][_i] = (unsigned)(S.arow(u, _h * HALF + sR[_i]) * K + sC[_i]) * 2u; } while (0)
    Unit cur, nxt; int ui = 0;
    if (!S.next(0, cur)) return;
    Acc acc;
#pragma unroll
    for (int a = 0; a < 2; ++a)
#pragma unroll
        for (int b = 0; b < 2; ++b)
#pragma unroll
            for (int m = 0; m < 4; ++m)
#pragma unroll
                for (int n = 0; n < 2; ++n) acc[a][b][m][n] = (f32x4){0.f, 0.f, 0.f, 0.f};
    bf16x8 At[4][2], B0[2][2], B1[2][2];
    unsigned cvA[2][2], nvA[2][2];
    G8_VOFFA(cvA, cur);
    const char* cA = (const char*)A; const char* cB = (const char*)cur.bt;
    G8_STAGE(G8_SB(0, 0), cB, voffB); G8_STAGE(G8_SA(0, 0), cA, cvA[0]); G8_STAGE(G8_SB(0, 1), cB + hstep, voffB); G8_STAGE(G8_SA(0, 1), cA, cvA[1]);
    if (wr == 1) S_BAR();
    WAIT_V(4); S_BAR();
    G8_STAGE(G8_SB(1, 0), cB + kstep, voffB); G8_STAGE(G8_SA(1, 0), cA + kstep, cvA[0]); G8_STAGE(G8_SB(1, 1), cB + hstep + kstep, voffB);
    WAIT_V(6); S_BAR();
    for (;;) {
        const bool has_next = S.next(ui + 1, nxt);
        if (has_next) { G8_VOFFA(nvA, nxt); } else {
#pragma unroll
            for (int h = 0; h < 2; ++h)
#pragma unroll
                for (int i = 0; i < 2; ++i) nvA[h][i] = cvA[h][i]; }
        const char* nB = has_next ? (const char*)nxt.bt : cB;
        for (int t = 0; t < nt; t += 2) {
            const bool last = (t == nt - 2);
            const char* a1 = cA + (size_t)(t + 1) * kstep;
            const char* a2 = last ? cA : cA + (size_t)(t + 2) * kstep; const char* b2 = last ? nB : cB + (size_t)(t + 2) * kstep;
            const char* a3 = a2 + kstep; const char* b3 = b2 + kstep;
            unsigned v2[2][2];
#pragma unroll
            for (int h = 0; h < 2; ++h)
#pragma unroll
                for (int i = 0; i < 2; ++i) v2[h][i] = last ? nvA[h][i] : cvA[h][i];
            G8_LDB(B0, 0, 0); SCHED_BAR(); G8_LDA(At, 0, 0); G8_STAGE(G8_SA(1, 1), a1, cvA[1]);
            WAIT_L(8); S_BAR(); WAIT_L(0); G8_MMA(0, 0, At, B0); S_BAR(); SCHED_BAR();
            G8_LDB(B1, 0, 1); G8_STAGE(G8_SB(0, 0), b2, voffB);
            S_BAR(); WAIT_L(0); G8_MMA(0, 1, At, B1); S_BAR();
            G8_LDA(At, 0, 1); G8_STAGE(G8_SA(0, 0), a2, v2[0]);
            S_BAR(); WAIT_L(0); G8_MMA(1, 0, At, B0); S_BAR(); SCHED_BAR();
            G8_STAGE(G8_SB(0, 1), b2 + hstep, voffB);
            WAIT_V(6); S_BAR(); G8_MMA(1, 1, At, B1); S_BAR();
            G8_LDB(B0, 1, 0); SCHED_BAR(); G8_LDA(At, 1, 0); G8_STAGE(G8_SA(0, 1), a2, v2[1]);
            WAIT_L(8); S_BAR(); WAIT_L(0); G8_MMA(0, 0, At, B0); S_BAR(); SCHED_BAR();
            G8_LDB(B1, 1, 1); G8_STAGE(G8_SB(1, 0), b3, voffB);
            S_BAR(); WAIT_L(0); G8_MMA(0, 1, At, B1); S_BAR();
            G8_LDA(At, 1, 1); G8_STAGE(G8_SA(1, 0), a3, v2[0]);
            S_BAR(); WAIT_L(0); G8_MMA(1, 0, At, B0); S_BAR(); SCHED_BAR();
            G8_STAGE(G8_SB(1, 1), b3 + hstep, voffB);
            WAIT_V(6); S_BAR(); G8_MMA(1, 1, At, B1); S_BAR();
        }
        E(acc, cur, wr, wc, fr, fq);
        if (!has_next) break;
#pragma unroll
        for (int a = 0; a < 2; ++a)
#pragma unroll
            for (int b = 0; b < 2; ++b)
#pragma unroll
                for (int m = 0; m < 4; ++m)
#pragma unroll
                    for (int n = 0; n < 2; ++n) acc[a][b][m][n] = (f32x4){0.f, 0.f, 0.f, 0.f};
        cur = nxt; cB = nB; ++ui;
#pragma unroll
        for (int h = 0; h < 2; ++h)
#pragma unroll
            for (int i = 0; i < 2; ++i) cvA[h][i] = nvA[h][i];
    }
    WAIT_V(0);
    if (wr == 0) S_BAR();
    S_BAR();
#undef G8_SA
#undef G8_SB
#undef G8_STAGE
#undef G8_LDA
#undef G8_LDB
#undef G8_MMA
#undef G8_VOFFA
}

struct DenseOrder {
    int nM, nN, nwg, G, c; const bf16_t* Bt; int K;
    __device__ __forceinline__ void init(int M, int N, int K_, const bf16_t* Bt_, int G_, int c_) { nM = M / BM; nN = N / BM; nwg = nM * nN; G = G_; c = c_; Bt = Bt_; K = K_; }
    __device__ __forceinline__ bool next(int i, Unit& u) const {
        const long L = (long)i * G + c; if (L >= nwg) return false;
        int wgid = (int)L; { const int q = nwg / 8, r = nwg % 8, xcd = wgid % 8, off = wgid / 8; wgid = (xcd < r ? xcd * (q + 1) : r * (q + 1) + (xcd - r) * q) + off; }
        const int nig = 8 * nN, gid = wgid / nig, fm = gid * 8, gsz = (nM - fm) < 8 ? (nM - fm) : 8;
        u.pm = fm + ((wgid % nig) % gsz); u.pn = (wgid % nig) / gsz; u.bt = Bt + (size_t)u.pn * BM * K; u.e = 0; return true;
    }
    __device__ __forceinline__ int arow(const Unit& u, int r) const { return u.pm * BM + r; }
};
}

constexpr int PWP = 3328;
struct EpiIn {
    bf16_t* P; const float* rope;
    __device__ __forceinline__ void operator()(const g8::Acc& acc, const g8::Unit& u, int wr, int wc, int fr, int fq) const {
#pragma unroll
        for (int ai = 0; ai < 2; ++ai)
#pragma unroll
            for (int m = 0; m < 4; ++m) {
                const int row = u.pm * 256 + ai * 128 + wr * 64 + m * 16 + fr;
                const int s = row % S, prow = s >> 6, pcol = s & 63;
#pragma unroll
                for (int bj = 0; bj < 2; ++bj) {
                    const int c0 = u.pn * 256 + bj * 128 + wc * 32 + 4 * fq;
                    f32x4 v0 = acc[ai][bj][m][0], v1 = acc[ai][bj][m][1];
                    if (c0 < C_VA && row < NL) {
                        const int pos = (c0 & 32) ? pcol : prow;
#pragma unroll
                        for (int j = 0; j < 4; ++j) {
                            const float cs = rope[(pos * 16 + 4 * fq + j) * 2], sn = rope[(pos * 16 + 4 * fq + j) * 2 + 1];
                            const float a = v0[j], b = v1[j];
                            v0[j] = a * cs - b * sn; v1[j] = b * cs + a * sn;
                        }
                    }
#pragma unroll
                    for (int n = 0; n < 2; ++n) {
                        const int c = c0 + 16 * n;
                        float sc = 1.0f;
                        if (c < C_KA) sc = 0.125f * LOG2E;
                        else if (c >= C_QB && c < C_KB) sc = 0.17677669529663687f;
                        else if (c >= C_QN && c < C_KN) sc = 0.125f * LOG2E;
                        const f32x4 v = n ? v1 : v0;
                        if (c < PW) { u32x2 o; o[0] = pack2(v[0] * sc, v[1] * sc); o[1] = pack2(v[2] * sc, v[3] * sc); *(u32x2*)(P + (size_t)row * PW + c) = o; }
                    }
                }
            }
    }
};
__device__ void phase_gemm_in(const PP& p, int l, char* lds) {
    g8::DenseOrder S; S.init(NT, PWP, D, (const bf16_t*)(p.ws + OFF_WIN) + (size_t)l * PWP * D, GDIM(), BID());
    float* rope_l = (float*)(lds + g8::STAGE_BYTES + 1024);
    __syncthreads();
    for (int e = TID(); e < 64 * 16 * 2; e += NTHREADS) rope_l[e] = ((const float*)(p.ws + OFF_ROPE))[e];
    __syncthreads();
    EpiIn epi{(bf16_t*)(p.ws + OFF_P), rope_l};
    g8::gemm_phase(lds, (const bf16_t*)(p.ws + OFF_H), D, S, epi);
}

struct EpiOut {
    bf16_t* XD; const float* mod_l;
    __device__ __forceinline__ void operator()(const g8::Acc& acc, const g8::Unit& u, int wr, int wc, int fr, int fq) const {
        const float* g = mod_l + (size_t)tok_batch(u.pm * 256) * 6 * D + 2 * D;
        f32x4 gv[2][2];
        const bool uni = (NL % 256 == 0) && (S % 256 == 0) && (L % 256 == 0);
        if (uni) {
#pragma unroll
            for (int bj = 0; bj < 2; ++bj)
#pragma unroll
                for (int n = 0; n < 2; ++n) gv[bj][n] = *(const f32x4*)(g + u.pn * 256 + bj * 128 + wc * 32 + 16 * n + 4 * fq);
        }
#pragma unroll
        for (int ai = 0; ai < 2; ++ai)
#pragma unroll
            for (int m = 0; m < 4; ++m) {
                const int row = u.pm * 256 + ai * 128 + wr * 64 + m * 16 + fr;
                const float* gr = mod_l + (size_t)tok_batch(row) * 6 * D + 2 * D;
#pragma unroll
                for (int bj = 0; bj < 2; ++bj)
#pragma unroll
                    for (int n = 0; n < 2; ++n) {
                        const int c = u.pn * 256 + bj * 128 + wc * 32 + 16 * n + 4 * fq;
                        const f32x4 gq = uni ? gv[bj][n] : *(const f32x4*)(gr + c); const f32x4 a = acc[ai][bj][m][n];
                        u32x2 o; o[0] = pack2(gq[0] * a[0], gq[1] * a[1]); o[1] = pack2(gq[2] * a[2], gq[3] * a[3]);
                        *(u32x2*)(XD + (size_t)row * D + c) = o;
                    }
            }
    }
};
struct OneUnitOrder {
    int pm, pn; const bf16_t* Bt; int K;
    __device__ __forceinline__ bool next(int i, g8::Unit& u) const { if (i > 0) return false; u.pm = pm; u.pn = pn; u.bt = Bt + (size_t)pn * g8::BM * K; u.e = 0; return true; }
    __device__ __forceinline__ int arow(const g8::Unit& u, int r) const { return u.pm * g8::BM + r; }
};
__device__ void phase_gemm_out(const PP& p, int l, char* lds) {
    const int M = NL;
    g8::DenseOrder S; S.init(M, D, MIXW, (const bf16_t*)(p.ws + OFF_WOUT) + (size_t)l * D * MIXW, GDIM(), BID());
    EpiOut epi{(bf16_t*)(p.ws + OFF_XD), (const float*)(p.ws + OFF_MOD) + (size_t)l * (NB + 1) * 6 * D};
    g8::gemm_phase(lds, (const bf16_t*)(p.ws + OFF_MIX), MIXW, S, epi);
}

struct MoeOrder {
    const int* ps; const int* cn; const int* list; const bf16_t* W; int nN, K, nwg, G, c; size_t wstride; int up;
    __device__ __forceinline__ bool next(int i, g8::Unit& u) const {
        const long Lx = (long)i * G + c; if (Lx >= nwg) return false;
        const int mt = (int)Lx / nN; u.pn = (int)Lx % nN; u.pm = mt;
        int e = 0; while (e < NEXP - 1 && ps[e + 1] <= mt * 256) ++e;
        u.e = e; u.bt = W + (size_t)e * wstride + (size_t)u.pn * 256 * K; return true;
    }
    __device__ __forceinline__ int arow(const g8::Unit& u, int r) const {
        if (!up) return u.pm * 256 + r;
        int s = u.pm * 256 - ps[u.e] + r; const int cnt = cn[u.e]; s = s < cnt ? s : cnt - 1;
        return list[(size_t)u.e * NT + s];
    }
};
struct EpiUp {
    bf16_t* act; const int* ps; const int* cn;
    __device__ __forceinline__ void operator()(const g8::Acc& acc, const g8::Unit& u, int wr, int wc, int fr, int fq) const {
        const int lim = ps[u.e] + cn[u.e];
#pragma unroll
        for (int ai = 0; ai < 2; ++ai)
#pragma unroll
            for (int m = 0; m < 4; ++m) {
                const int row = u.pm * 256 + ai * 128 + wr * 64 + m * 16 + fr;
                if (row < lim) {
#pragma unroll
                    for (int bj = 0; bj < 2; ++bj) {
                        const int c = u.pn * 256 + bj * 128 + wc * 32 + 4 * fq;
                        const int j = (c >> 5) * 16 + (c & 15);
                        const f32x4 g = acc[ai][bj][m][0], uu = acc[ai][bj][m][1];
                        u32x2 o; o[0] = pack2(silu_fast(g[0]) * uu[0], silu_fast(g[1]) * uu[1]); o[1] = pack2(silu_fast(g[2]) * uu[2], silu_fast(g[3]) * uu[3]);
                        *(u32x2*)(act + (size_t)row * EH + j) = o;
                    }
                }
            }
    }
};
struct EpiDown {
    bf16_t* y; const int* ps; const int* cn;
    __device__ __forceinline__ void operator()(const g8::Acc& acc, const g8::Unit& u, int wr, int wc, int fr, int fq) const {
        const int lim = ps[u.e] + cn[u.e];
#pragma unroll
        for (int ai = 0; ai < 2; ++ai)
#pragma unroll
            for (int m = 0; m < 4; ++m) {
                const int row = u.pm * 256 + ai * 128 + wr * 64 + m * 16 + fr;
                if (row < lim) {
#pragma unroll
                    for (int bj = 0; bj < 2; ++bj)
#pragma unroll
                        for (int n = 0; n < 2; ++n) {
                            const int c = u.pn * 256 + bj * 128 + wc * 32 + 16 * n + 4 * fq; const f32x4 a = acc[ai][bj][m][n];
                            u32x2 o; o[0] = pack2(a[0], a[1]); o[1] = pack2(a[2], a[3]);
                            *(u32x2*)(y + (size_t)row * D + c) = o;
                        }
                }
            }
    }
};
template <int UP>
__device__ void phase_moe(const PP& p, int l, char* lds) {
    int* ps = (int*)(lds + g8::STAGE_BYTES);
    int* cn = ps + 40;
    __syncthreads();
    load_pad_start(p, l, ps);
    if (TID() < NEXP) cn[TID()] = ((const int*)(p.ws + OFF_CNT))[l * NEXP + TID()];
    __syncthreads();
    MoeOrder S; S.ps = ps; S.cn = cn; S.list = (const int*)(p.ws + OFF_LIST); S.G = GDIM(); S.c = BID(); S.up = UP;
    if (UP) { S.nN = 2 * EH / 256; S.K = D; S.W = (const bf16_t*)(p.ws + OFF_WUP) + (size_t)l * NEXP * 2 * EH * D; S.wstride = (size_t)2 * EH * D; }
    else { S.nN = D / 256; S.K = EH; S.W = (const bf16_t*)(p.ws + OFF_WDN) + (size_t)l * NEXP * D * EH; S.wstride = (size_t)D * EH; }
    S.nwg = (ps[NEXP] / 256) * S.nN;
    if (UP) { EpiUp epi{(bf16_t*)(p.ws + OFF_ACT), ps, cn}; g8::gemm_phase(lds, (const bf16_t*)(p.ws + OFF_H), D, S, epi); }
    else { EpiDown epi{(bf16_t*)(p.ws + OFF_Y), ps, cn}; g8::gemm_phase(lds, (const bf16_t*)(p.ws + OFF_ACT), EH, S, epi); }
}

template <int NMAP, int DV> struct AttnLds {
    static constexpr int RB = NMAP * 128, VSTR = DV * 2;
    static constexpr int Q_BYTES = 256 * RB, K_BYTES = 64 * RB, V_BYTES = 64 * VSTR, TOTAL = Q_BYTES + 2 * K_BYTES + 2 * V_BYTES;
};
#ifdef EMU
__device__ __forceinline__ bf16x4 tr_read_b64(const char* addr) {
    const char* a = addr; char* b = emu::wave_xchg(&a, sizeof(a));
    const int lane = threadIdx.x & 63, g = lane >> 4, i = lane & 15; bf16x4 r;
    for (int q = 0; q < 4; ++q) { const char* src = *(const char**)(b + (size_t)(16 * g + 4 * q + (i >> 2)) * 64); r[q] = *(const short*)(src + 2 * (i & 3)); }
    return r;
}
#define TR_READ(dst, base, OFF) dst = tr_read_b64((base) + (OFF))
#define LGKM_WAIT0() do {} while (0)
#define LGKM_WAITN(n) do {} while (0)
#else
#define TR_READ(dst, base, OFF) dst = __builtin_amdgcn_ds_read_tr16_b64_v4i16((LAS3 bf16x4*)((base) + (OFF)))
#define LGKM_WAIT0() do {} while (0)
#define LGKM_WAITN(n) do {} while (0)
#endif

struct MaskNone { __device__ __forceinline__ bool tile_valid(int) const { return true; } __device__ __forceinline__ float operator()(float s, int, int) const { return s; } };
struct MaskNA {
    const float* bias;
    int rq, cq, rs, rlo;
    __device__ __forceinline__ bool tile_valid(int kt) const { if (kt < LC) return true; const int kr = rlo + kt - LC; return kr >= rs && kr < rs + 8; }
    __device__ __forceinline__ float operator()(float s, int kt, int kc) const {
        if (kt < LC) return s;
        const int kr = rlo + kt - LC;
        int cs = cq - 8; cs = cs < 0 ? 0 : (cs > 48 ? 48 : cs);
        if (kc < cs || kc >= cs + 16) return -INFINITY;
        int dc = kc - cq; dc = dc < -15 ? -15 : (dc > 15 ? 15 : dc);
        return s + bias[(kr - rq + 7) * 31 + dc + 15];
    }
};

constexpr float ATTN_THR = 11.0f;

template <int NMAP, int DV, class KTok, class MaskF>
__device__ void attn_item(const PP& p, char* lds, int q0, int nq, int nkt, KTok ktok, int qcol, int kcol, int vcol, int ocol, MaskF mask, int layer) {
    typedef AttnLds<NMAP, DV> LL;
    constexpr int RB = LL::RB, VSTR = LL::VSTR, NDB = DV / 32;
    constexpr int KCH = 64 * RB / 16 / NTHREADS, VCH = 64 * DV / 8 / NTHREADS;
    const bf16_t* P = (const bf16_t*)(p.ws + OFF_P);
    bf16_t* MIX = (bf16_t*)(p.ws + OFF_MIX);
    char* Qs = lds; char* Ks = lds + LL::Q_BYTES; char* Vs = Ks + 2 * LL::K_BYTES;
    const int tid = TID(), lane = tid & 63, wave = tid >> 6, r32 = lane & 31, hh = lane >> 5;
    const bool active = wave * 32 < nq;
    __syncthreads();
    for (int c = tid; c < 256 * RB / 16; c += NTHREADS) {
        const int row = c / (RB / 16), ch = c % (RB / 16);
        u32x4 v = {0u, 0u, 0u, 0u};
        if (row < nq) v = *(const u32x4*)(P + (size_t)(q0 + row) * PW + qcol + ch * 8);
        *(u32x4*)(Qs + row * RB + ((ch * 16) ^ ((row & 7) << 4))) = v;
    }
    const int wid = READFIRSTLANE(wave);
    constexpr int KI = LL::K_BYTES / 1024 / 8, VI = LL::V_BYTES / 1024 / 8;
    constexpr int KCPR = RB / 16, VCPR = VSTR / 16;
#define A_KGO(i) ({ const int slot_ = (wid * KI + (i)) * 64 + lane, row_ = slot_ / KCPR, ch_ = (slot_ % KCPR) ^ (row_ & 7); row_ * PW + kcol + ch_ * 8; })
#define A_VGO(i) ({ const int slot_ = (wid * VI + (i)) * 64 + lane, row_ = slot_ / VCPR; const int sw_ = DV == 128 ? ((row_ & 3) << 2) : (((row_ >> 1) & 1) << 2); row_ * PW + vcol + (((slot_ % VCPR) ^ sw_) * 8); })
#define A_LOAD(kt_, b_) do { const bf16_t* t0_ = P + (size_t)ktok(kt_) * PW; \
        _Pragma("unroll") for (int i = 0; i < KI; ++i) GLDS16_ASM(t0_ + A_KGO(i), Ks + (b_) * LL::K_BYTES + (wid * KI + i) * 1024); \
        _Pragma("unroll") for (int i = 0; i < VI; ++i) GLDS16_ASM(t0_ + A_VGO(i), Vs + (b_) * LL::V_BYTES + (wid * VI + i) * 1024); } while (0)
    const int kx = (hh * 16) ^ ((r32 & 7) << 4);
#define koff_(ks) (kx ^ ((ks) * 32))
    const char* qrow = Qs + (wave * 32 + r32) * RB;
    const int g16 = lane >> 4, i16 = lane & 15;
    const int vq = i16 >> 2, vsw = DV == 128 ? vq : ((vq >> 1) & 1);
    const int vb0 = (4 * hh + vq) * VSTR + 32 * (g16 & 1) + 8 * (i16 & 3);
#define vbd_(d) (vb0 + (((d) ^ vsw) << 6))
    f32x16 O[NMAP][NDB];
    float mrun[NMAP], lrun[NMAP];
#pragma unroll
    for (int m = 0; m < NMAP; ++m) { mrun[m] = -1e30f; lrun[m] = 0.f;
#pragma unroll
        for (int d = 0; d < NDB; ++d)
#pragma unroll
            for (int i = 0; i < 16; ++i) O[m][d][i] = 0.f; }
    A_LOAD(0, 0);
    WAIT_V(0);
    __syncthreads();
    bf16x8 qfr[NMAP][4];
#pragma unroll
    for (int m = 0; m < NMAP; ++m)
#pragma unroll
        for (int ks = 0; ks < 4; ++ks) qfr[m][ks] = *(const bf16x8*)(qrow + m * 128 + koff_(ks));
    for (int kt = 0; kt < nkt; ++kt) {
        const int b = kt & 1;
        if (kt + 1 < nkt) A_LOAD(kt + 1, b ^ 1);
        if (active && mask.tile_valid(kt)) {
            const char* Kb = Ks + b * LL::K_BYTES; const char* Vb = Vs + b * LL::V_BYTES;
#pragma unroll
            for (int kb = 0; kb < 2; ++kb) {
                bf16x8 pf[NMAP][2];
#pragma unroll
                for (int m = 0; m < NMAP; ++m) {
                    f32x16 st;
#pragma unroll
                    for (int i = 0; i < 16; ++i) st[i] = 0.f;
#pragma unroll
                    for (int ks = 0; ks < 4; ++ks) {
                        const bf16x8 a = *(const bf16x8*)(Kb + (kb * 32 + r32) * RB + m * 128 + koff_(ks));
                        st = MFMA32(a, qfr[m][ks], st);
                    }
                    float mx = -INFINITY;
#pragma unroll
                    for (int i = 0; i < 16; ++i) { const int kc = kb * 32 + (i & 3) + 8 * (i >> 2) + 4 * hh; const float sv = mask(st[i], kt, kc); st[i] = sv; mx = fmaxf(mx, sv); }
                    mx = xhalf_max(mx);
                    if (!__all(mx - mrun[m] <= ATTN_THR)) {
                        const float mnew = fmaxf(mrun[m], mx), alpha = EXP2F(mrun[m] - mnew);
                        mrun[m] = mnew; lrun[m] *= alpha;
#pragma unroll
                        for (int d = 0; d < NDB; ++d)
#pragma unroll
                            for (int i = 0; i < 16; ++i) O[m][d][i] *= alpha;
                    }
                    const float mr = mrun[m];
                    float ls = 0.f;
#pragma unroll
                    for (int s2 = 0; s2 < 2; ++s2) {
                        u32x4 pk;
#pragma unroll
                        for (int j = 0; j < 4; ++j) { const float p0 = EXP2F(st[8 * s2 + 2 * j] - mr), p1 = EXP2F(st[8 * s2 + 2 * j + 1] - mr); ls += p0 + p1; pk[j] = pack2(p0, p1); }
                        pf[m][s2] = __builtin_bit_cast(bf16x8, pk);
                    }
                    lrun[m] += ls;
                }
                bf16x4 va[2][4];
#define A_TR(set_, d_) do { TR_READ(va[set_][0], Vb + vbd_(d_), (kb * 32) * VSTR); TR_READ(va[set_][1], Vb + vbd_(d_), (kb * 32 + 8) * VSTR); \
                            TR_READ(va[set_][2], Vb + vbd_(d_), (kb * 32 + 16) * VSTR); TR_READ(va[set_][3], Vb + vbd_(d_), (kb * 32 + 24) * VSTR); } while (0)
#pragma unroll
                for (int d = 0; d < NDB; ++d) {
                    A_TR(0, d); LGKM_WAITN(0);
                    const bf16x4* v_ = va[0];
                    const bf16x8 av0 = {v_[0][0], v_[0][1], v_[0][2], v_[0][3], v_[1][0], v_[1][1], v_[1][2], v_[1][3]};
                    const bf16x8 av1 = {v_[2][0], v_[2][1], v_[2][2], v_[2][3], v_[3][0], v_[3][1], v_[3][2], v_[3][3]};
                    SETPRIO(1);
#pragma unroll
                    for (int m = 0; m < NMAP; ++m) O[m][d] = MFMA32(av0, pf[m][0], O[m][d]);
#pragma unroll
                    for (int m = 0; m < NMAP; ++m) O[m][d] = MFMA32(av1, pf[m][1], O[m][d]);
                    SETPRIO(0);
                }
#undef A_TR
            }
        }
        WAIT_V(0);
        __syncthreads();
    }
#undef A_LOAD
#undef A_KGO
#undef A_VGO
#undef koff_
#undef vbd_
    if (active) {
        float lam = 0.f, post_scale = 1.0f; const float* g_sub = p.sm(OFF_S_GSUB) + (size_t)layer * 128;
        if (NMAP == 2) {
            const float lam_init = 0.8f - 0.6f * expf(-0.3f * (float)layer);
            const float* lm = p.sm(OFF_S_LAM) + (size_t)layer * 4 * 64; float a = 0.f, b2 = 0.f;
            for (int i = 0; i < 64; ++i) { a += lm[i] * lm[64 + i]; b2 += lm[128 + i] * lm[192 + i]; }
            lam = expf(a) - expf(b2) + lam_init; post_scale = 1.0f - lam_init;
        }
        float inv[NMAP];
#pragma unroll
        for (int m = 0; m < NMAP; ++m) { const float lt = xhalf_sum(lrun[m]); inv[m] = 1.0f / lt; }
        float ss = 0.f;
#pragma unroll
        for (int d = 0; d < NDB; ++d)
#pragma unroll
            for (int i = 0; i < 16; ++i) {
                float o = O[0][d][i] * inv[0];
                if (NMAP == 2) o -= lam * O[NMAP - 1][d][i] * inv[NMAP - 1];
                O[0][d][i] = o; ss += o * o;
            }
        float rs = 1.0f;
        if (NMAP == 2) { ss = xhalf_sum(ss); rs = post_scale / sqrtf(ss / (float)DV + NORM_EPS); }
        const int tok = q0 + wave * 32 + r32;
#pragma unroll
        for (int d = 0; d < NDB; ++d)
#pragma unroll
            for (int g = 0; g < 4; ++g) {
                const int dd = d * 32 + 8 * g + 4 * hh;
                float v0 = O[0][d][4 * g] * rs, v1 = O[0][d][4 * g + 1] * rs, v2 = O[0][d][4 * g + 2] * rs, v3 = O[0][d][4 * g + 3] * rs;
                if (NMAP == 2) { v0 *= g_sub[dd]; v1 *= g_sub[dd + 1]; v2 *= g_sub[dd + 2]; v3 *= g_sub[dd + 3]; }
                u32x2 o; o[0] = pack2(v0, v1); o[1] = pack2(v2, v3);
                *(u32x2*)(MIX + (size_t)tok * MIXW + ocol + dd) = o;
            }
    }
}

struct KTokDiff { int b; __device__ __forceinline__ int operator()(int kt) const { return kt < LC ? NL + b * L + kt * 64 : b * S + (kt - LC) * 64; } };
struct KTokCtx { int b; __device__ __forceinline__ int operator()(int kt) const { return NL + b * L + kt * 64; } };
struct KTokNA { int b, rlo; __device__ __forceinline__ int operator()(int kt) const { return kt < LC ? NL + b * L + kt * 64 : b * S + (rlo + kt - LC) * 64; } };

constexpr int GL_QS = 80;
constexpr int GL_VS = 192;
constexpr int GL_OP = 64 * GL_QS;
constexpr int GL_DIR = 4 * GL_OP + 64 * GL_VS + 2 * GL_OP + 256;
constexpr int GL_WD = 2 * (16 * 32 + 32) * 4;
constexpr int GLA_LDS = 2 * GL_DIR + GL_WD + 256;
constexpr size_t OPART_CH = 4096;

__device__ __forceinline__ int gla_chunk_tok(int b, int c) { return c < LC ? NL + b * L + c * 64 : b * S + (c - LC) * 64; }
__device__ __forceinline__ int gla_bwd_chunk(int i) { return i < LC ? LC - 1 - i : NCH - 1 - (i - LC); }
__device__ __forceinline__ int gla_bwd_step(int c) { return c < LC ? LC - 1 - c : LC + NCH - 1 - c; }

__device__ void gla_chain_item(const PP& p, int l, int b, int h, char* lds) {
    const int tid = TID(), lane = tid & 63, wave = tid >> 6, r32 = lane & 31, hh = lane >> 5, g16 = lane >> 4, i16 = lane & 15;
    const bf16_t* P = (const bf16_t*)(p.ws + OFF_P);
    bf16_t* MIX = (bf16_t*)(p.ws + OFF_MIX);
    float* OPART = (float*)(p.ws + OFF_GKV) + (size_t)(b * 4 + h) * 2 * NCH * OPART_CH;
    float* wdl = (float*)(lds + 2 * GL_DIR);
    const int pd = wave >> 2, pq = wave & 3, tl = pd == 0 ? lane : 63 - lane;
    char* L_own = lds + pd * GL_DIR;
    __syncthreads();
    for (int e = tid; e < 2 * 16 * 32; e += NTHREADS) { const int d = e >> 9, r = (e >> 5) & 15, k = e & 31; wdl[e] = p.sm(OFF_S_WDEC)[(((size_t)l * 2 + d) * 16 + r) * 128 + h * 32 + k]; }
    if (tid < 64) { const int d = tid >> 5, k = tid & 31; wdl[1024 + tid] = p.sm(OFF_S_BDEC)[((size_t)l * 2 + d) * 128 + h * 32 + k]; }
    for (int e = tid; e < 2 * GL_OP / 4; e += NTHREADS) { const int d = e / (GL_OP / 4), o = e % (GL_OP / 4); ((unsigned*)(lds + d * GL_DIR + 4 * GL_OP + 64 * GL_VS))[o] = 0u; }
    __syncthreads();
    u32x4 rq, rk, rg0, rg1, rv0, rv1;
    const int vid0 = pq * 64 + lane, vid1 = vid0 + 256;
#define GL_FETCH(step_) do { const int c_ = pd == 0 ? (step_) : gla_bwd_chunk(step_); const bf16_t* base_ = P + (size_t)gla_chunk_tok(b, c_) * PW; \
        const bf16_t* row_ = base_ + (size_t)tl * PW; \
        rq = *(const u32x4*)(row_ + C_QB + h * 32 + pq * 8); rk = *(const u32x4*)(row_ + C_KB + h * 32 + pq * 8); \
        rg0 = *(const u32x4*)(row_ + C_GB + pd * 16); rg1 = *(const u32x4*)(row_ + C_GB + pd * 16 + 8); \
        rv0 = *(const u32x4*)(base_ + (size_t)(vid0 >> 3) * PW + C_VB + h * 64 + (vid0 & 7) * 8); \
        rv1 = *(const u32x4*)(base_ + (size_t)(vid1 >> 3) * PW + C_VB + h * 64 + (vid1 & 7) * 8); } while (0)
    GL_FETCH(0);
    const bool out_role = wave < 4;
    const int cd = out_role ? (wave >> 1) : ((wave - 4) >> 1), cblk = wave & 1;
    char* L_c = lds + cd * GL_DIR;
    f32x16 Sst;
#pragma unroll
    for (int i = 0; i < 16; ++i) Sst[i] = 0.f;
    for (int step = 0; step < NCH; ++step) {
        {
            float gv[16];
            { const unsigned gw[8] = {rg0[0], rg0[1], rg0[2], rg0[3], rg1[0], rg1[1], rg1[2], rg1[3]};
#pragma unroll
              for (int j = 0; j < 8; ++j) { gv[2 * j] = u2f(gw[j] << 16); gv[2 * j + 1] = u2f(gw[j] & 0xffff0000u); } }
            float bb[8];
            const float* wdp = wdl + pd * 512 + pq * 8;
#pragma unroll
            for (int j = 0; j < 8; ++j) bb[j] = wdl[1024 + pd * 32 + pq * 8 + j];
#pragma unroll
            for (int r = 0; r < 16; ++r) { const f32x4 w0 = *(const f32x4*)(wdp + r * 32), w1 = *(const f32x4*)(wdp + r * 32 + 4);
                bb[0] += gv[r] * w0[0]; bb[1] += gv[r] * w0[1]; bb[2] += gv[r] * w0[2]; bb[3] += gv[r] * w0[3];
                bb[4] += gv[r] * w1[0]; bb[5] += gv[r] * w1[1]; bb[6] += gv[r] * w1[2]; bb[7] += gv[r] * w1[3]; }
#pragma unroll
            for (int j = 0; j < 8; ++j) bb[j] = log_sigmoid_fast(bb[j]) * (1.0f / 16.0f);
#pragma unroll
            for (int o = 1; o < 64; o <<= 1) {
#pragma unroll
                for (int j = 0; j < 8; ++j) { const float t = __shfl_up(bb[j], o); if (lane >= o) bb[j] += t; }
            }
            float qv[8], kv[8];
            { const unsigned qw[4] = {rq[0], rq[1], rq[2], rq[3]}, kw_[4] = {rk[0], rk[1], rk[2], rk[3]};
#pragma unroll
              for (int j = 0; j < 4; ++j) { qv[2 * j] = u2f(qw[j] << 16); qv[2 * j + 1] = u2f(qw[j] & 0xffff0000u); kv[2 * j] = u2f(kw_[j] << 16); kv[2 * j + 1] = u2f(kw_[j] & 0xffff0000u); } }
            float e_qe[8], e_ke[8], e_qf[8], e_kw[8];
#pragma unroll
            for (int j = 0; j < 8; ++j) {
                const float bref = __shfl(bb[j], 31), bend = __shfl(bb[j], 63);
                e_qe[j] = qv[j] * exp_fast(bb[j] - bref); e_ke[j] = kv[j] * exp_fast(bref - bb[j]); e_qf[j] = qv[j] * exp_fast(bb[j]); e_kw[j] = kv[j] * exp_fast(bend - bb[j]);
                if (lane == 63) ((float*)(L_own + 4 * GL_OP + 64 * GL_VS + 2 * GL_OP))[pq * 8 + j] = exp_fast(bend);
            }
            char* rowp = L_own + tl * GL_QS + pq * 16;
            u32x4 o;
            o = (u32x4){pack2(e_qe[0], e_qe[1]), pack2(e_qe[2], e_qe[3]), pack2(e_qe[4], e_qe[5]), pack2(e_qe[6], e_qe[7])}; *(u32x4*)(rowp) = o;
            o = (u32x4){pack2(e_ke[0], e_ke[1]), pack2(e_ke[2], e_ke[3]), pack2(e_ke[4], e_ke[5]), pack2(e_ke[6], e_ke[7])}; *(u32x4*)(rowp + GL_OP) = o;
            o = (u32x4){pack2(e_qf[0], e_qf[1]), pack2(e_qf[2], e_qf[3]), pack2(e_qf[4], e_qf[5]), pack2(e_qf[6], e_qf[7])}; *(u32x4*)(rowp + 2 * GL_OP) = o;
            o = (u32x4){pack2(e_kw[0], e_kw[1]), pack2(e_kw[2], e_kw[3]), pack2(e_kw[4], e_kw[5]), pack2(e_kw[6], e_kw[7])}; *(u32x4*)(rowp + 3 * GL_OP) = o;
            *(u32x4*)(L_own + 4 * GL_OP + (vid0 >> 3) * GL_VS + (vid0 & 7) * 16) = rv0;
            *(u32x4*)(L_own + 4 * GL_OP + (vid1 >> 3) * GL_VS + (vid1 & 7) * 16) = rv1;
        }
        if (step + 1 < NCH) GL_FETCH(step + 1);
        float th[2][16]; u32x2 rgv[2][4];
        bool fin = false; int fcc = 0, ftok = 0;
        if (out_role) {
            fcc = cd == 0 ? step : gla_bwd_chunk(step);
            const int other_step = cd == 0 ? gla_bwd_step(fcc) : fcc;
            fin = other_step < step;
            ftok = gla_chunk_tok(b, fcc) + cblk * 32 + r32;
            if (fin) {
                const float* theirs = OPART + ((size_t)(1 - cd) * NCH + fcc) * OPART_CH;
                const bf16_t* rg = P + (size_t)ftok * PW + C_RB + h * 64;
#pragma unroll
                for (int vb = 0; vb < 2; ++vb) {
#pragma unroll
                    for (int i = 0; i < 16; ++i) th[vb][i] = theirs[(vb * 32 + (i & 3) + 8 * (i >> 2) + 4 * hh) * 64 + cblk * 32 + r32];
#pragma unroll
                    for (int g = 0; g < 4; ++g) rgv[vb][g] = *(const u32x2*)(rg + vb * 32 + 8 * g + 4 * hh);
                }
            }
        }
        __syncthreads();
        const int cc = cd == 0 ? step : gla_bwd_chunk(step);
        const char* Lqe = L_c, * Lke = L_c + GL_OP, * Lqf = L_c + 2 * GL_OP, * Lkw = L_c + 3 * GL_OP, * Lv = L_c + 4 * GL_OP;
        const char* Lsr = L_c + 4 * GL_OP + 64 * GL_VS + (step & 1) * GL_OP;
        char* Lsw = L_c + 4 * GL_OP + 64 * GL_VS + ((step + 1) & 1) * GL_OP;
        if (out_role) {
            bf16x8 pf[2][2];
#pragma unroll
            for (int sb = 0; sb < 2; ++sb) {
                f32x16 at;
#pragma unroll
                for (int i = 0; i < 16; ++i) at[i] = 0.f;
#pragma unroll
                for (int ks = 0; ks < 2; ++ks) {
                    const bf16x8 a = *(const bf16x8*)(Lke + (sb * 32 + r32) * GL_QS + ks * 32 + hh * 16);
                    const bf16x8 bq = *(const bf16x8*)(Lqe + (cblk * 32 + r32) * GL_QS + ks * 32 + hh * 16);
                    at = MFMA32(a, bq, at);
                }
                const int tt = cblk * 32 + r32;
#pragma unroll
                for (int s2 = 0; s2 < 2; ++s2) {
                    u32x4 pk;
#pragma unroll
                    for (int j = 0; j < 4; ++j) {
                        const int s0 = sb * 32 + ((8 * s2 + 2 * j) & 3) + 8 * ((8 * s2 + 2 * j) >> 2) + 4 * hh, s1 = s0 + 1;
                        const bool k0 = cd == 0 ? (s0 <= tt) : (s0 >= tt), k1 = cd == 0 ? (s1 <= tt) : (s1 >= tt);
                        pk[j] = pack2(k0 ? at[8 * s2 + 2 * j] : 0.f, k1 ? at[8 * s2 + 2 * j + 1] : 0.f);
                    }
                    pf[sb][s2] = __builtin_bit_cast(bf16x8, pk);
                }
            }
            f32x16 oacc[2];
            const int vb_ = (4 * hh + (i16 >> 2)) * GL_VS + (16 * (g16 & 1) + 4 * (i16 & 3)) * 2;
#pragma unroll
            for (int vb = 0; vb < 2; ++vb) {
#pragma unroll
                for (int i = 0; i < 16; ++i) oacc[vb][i] = 0.f;
#pragma unroll
                for (int ks = 0; ks < 2; ++ks) {
                    const bf16x8 a = *(const bf16x8*)(Lsr + (vb * 32 + r32) * GL_QS + ks * 32 + hh * 16);
                    const bf16x8 bq = *(const bf16x8*)(Lqf + (cblk * 32 + r32) * GL_QS + ks * 32 + hh * 16);
                    oacc[vb] = MFMA32(a, bq, oacc[vb]);
                }
                bf16x4 lo[2][2], hi[2][2];
#pragma unroll
                for (int sb = 0; sb < 2; ++sb)
#pragma unroll
                    for (int s2 = 0; s2 < 2; ++s2) {
                        TR_READ(lo[sb][s2], Lv + vb_, vb * 64 + (sb * 32 + s2 * 16) * GL_VS);
                        TR_READ(hi[sb][s2], Lv + vb_, vb * 64 + (sb * 32 + s2 * 16 + 8) * GL_VS);
                    }
                LGKM_WAIT0();
#pragma unroll
                for (int sb = 0; sb < 2; ++sb)
#pragma unroll
                    for (int s2 = 0; s2 < 2; ++s2) {
                        const bf16x8 av = {lo[sb][s2][0], lo[sb][s2][1], lo[sb][s2][2], lo[sb][s2][3], hi[sb][s2][0], hi[sb][s2][1], hi[sb][s2][2], hi[sb][s2][3]};
                        oacc[vb] = MFMA32(av, pf[sb][s2], oacc[vb]);
                    }
            }
            const int tt = cblk * 32 + r32;
            float* mine = OPART + ((size_t)cd * NCH + cc) * OPART_CH;
            if (!fin) {
#pragma unroll
                for (int vb = 0; vb < 2; ++vb)
#pragma unroll
                    for (int i = 0; i < 16; ++i) mine[(vb * 32 + (i & 3) + 8 * (i >> 2) + 4 * hh) * 64 + tt] = oacc[vb][i];
            } else {
                float ss = 0.f;
#pragma unroll
                for (int vb = 0; vb < 2; ++vb)
#pragma unroll
                    for (int i = 0; i < 16; ++i) { const float o = oacc[vb][i] + th[vb][i]; oacc[vb][i] = o; ss += o * o; }
                ss += __shfl_xor(ss, 32);
                const float rstd = 1.0f / sqrtf(ss / 64.0f + NORM_EPS);
                const float* gg = p.sm(OFF_S_GGLA) + l * 64;
#pragma unroll
                for (int vb = 0; vb < 2; ++vb)
#pragma unroll
                    for (int g = 0; g < 4; ++g) {
                        const int v0 = vb * 32 + 8 * g + 4 * hh;
                        const u32x2 rr = rgv[vb][g];
                        const float r0 = u2f(rr[0] << 16), r1 = u2f(rr[0] & 0xffff0000u), r2 = u2f(rr[1] << 16), r3 = u2f(rr[1] & 0xffff0000u);
                        u32x2 o;
                        o[0] = pack2(oacc[vb][4 * g] * rstd * gg[v0] * silu_fast(r0), oacc[vb][4 * g + 1] * rstd * gg[v0 + 1] * silu_fast(r1));
                        o[1] = pack2(oacc[vb][4 * g + 2] * rstd * gg[v0 + 2] * silu_fast(r2), oacc[vb][4 * g + 3] * rstd * gg[v0 + 3] * silu_fast(r3));
                        *(u32x2*)(MIX + (size_t)ftok * MIXW + 512 + h * 64 + v0) = o;
                    }
            }
        } else {
            const float dec = ((const float*)(L_c + 4 * GL_OP + 64 * GL_VS + 2 * GL_OP))[r32];
#pragma unroll
            for (int i = 0; i < 16; ++i) Sst[i] *= dec;
            const int rb_ = (8 * hh + (i16 >> 2));
            const int va_ = rb_ * GL_VS + (16 * (g16 & 1) + 4 * (i16 & 3)) * 2 + cblk * 64;
            const int kb_ = rb_ * GL_QS + (16 * (g16 & 1) + 4 * (i16 & 3)) * 2;
            bf16x4 alo[4], ahi[4], blo[4], bhi[4];
#pragma unroll
            for (int ks = 0; ks < 4; ++ks) {
                TR_READ(alo[ks], Lv + va_, (ks * 16) * GL_VS); TR_READ(ahi[ks], Lv + va_, (ks * 16 + 4) * GL_VS);
                TR_READ(blo[ks], Lkw + kb_, (ks * 16) * GL_QS); TR_READ(bhi[ks], Lkw + kb_, (ks * 16 + 4) * GL_QS);
            }
            LGKM_WAIT0();
#pragma unroll
            for (int ks = 0; ks < 4; ++ks) {
                const bf16x8 av = {alo[ks][0], alo[ks][1], alo[ks][2], alo[ks][3], ahi[ks][0], ahi[ks][1], ahi[ks][2], ahi[ks][3]};
                const bf16x8 bv = {blo[ks][0], blo[ks][1], blo[ks][2], blo[ks][3], bhi[ks][0], bhi[ks][1], bhi[ks][2], bhi[ks][3]};
                Sst = MFMA32(av, bv, Sst);
            }
#pragma unroll
            for (int i = 0; i < 16; ++i) *(bf16_t*)(Lsw + (cblk * 32 + (i & 3) + 8 * (i >> 2) + 4 * hh) * GL_QS + r32 * 2) = f2bf(Sst[i]);
        }
        WAIT_V(0);
        __syncthreads();
    }
#undef GL_FETCH
}

__device__ void phase_mixers(const PP& pin, int l, char* lds) {
    PP p = pin;
    const bool need_ctx = l < DEPTH - 1;
    constexpr int QB_PER = S / 256, QC_PER = (L + 255) / 256;
    constexpr int N_GLA = NB * 4;
    constexpr int N_DIFF = NB * 4 * QB_PER, N_DIFFC = NB * 4 * QC_PER;
    constexpr int NA_BLK = IMG_ROWS / 4;
    constexpr int N_NA = NB * 4 * NA_BLK, N_NAC = NB * 4;
    int* qi = (int*)(lds - 8);
    int* qctr = (int*)(p.ws + OFF_CNT + 2048) + l * 64;
#define Q_NEXT(qn_, lim_, it_) { __syncthreads(); if (TID() == 0) *qi = atomicAdd(qctr + (qn_), 1); __syncthreads(); it_ = *qi; if (it_ >= (lim_)) break; \
        { int z_ = 0; LAUNDER_S(z_); p.ws = pin.ws + z_; } LAUNDER_S(l); }
    int* ctxdone = qctr + 24;
#ifdef EMU
#define CTX_DONE() do { __syncthreads(); if (TID() == 0) atomicAdd(ctxdone, 1); } while (0)
#else
#define CTX_DONE() do { asm volatile("s_waitcnt vmcnt(0)" ::: "memory"); __syncthreads(); if (TID() == 0) { __builtin_amdgcn_fence(__ATOMIC_RELEASE, "agent"); atomicAdd(ctxdone, 1); } } while (0)
#endif
    for (;;) { int it; Q_NEXT(0, N_GLA, it);
        gla_chain_item(p, l, it >> 2, it & 3, lds);
        if (need_ctx) CTX_DONE();
    }
#ifdef EMU
    const int myx = BID() & 7;
#else
    const int myx = (int)(xb_xcc_id() & 7u);
#endif
    constexpr int DPX = (NB * 4 / 8) * QB_PER;
    for (int xo = 0; xo < 8; ++xo) {
        const int xq = (myx + xo) & 7;
        for (;;) { int j; Q_NEXT(8 + xq, DPX, j);
            const int pr = xq + 8 * (j / QB_PER), qb = j % QB_PER, h = pr & 3, b = pr >> 2;
            attn_item<2, 128>(p, lds, b * S + qb * 256, 256, NCH, KTokDiff{b}, C_QA + h * 128, C_KA + h * 128, C_VA + h * 128, h * 128, MaskNone(), l);
        }
    }
    if (need_ctx) for (;;) { int j; Q_NEXT(2, N_DIFFC, j);
        const int qb = j % QC_PER, h = (j / QC_PER) & 3, b = j / (QC_PER * 4);
        attn_item<2, 128>(p, lds, NL + b * L + qb * 256, (L - qb * 256) < 256 ? (L - qb * 256) : 256, LC, KTokCtx{b}, C_QA + h * 128, C_KA + h * 128, C_VA + h * 128, h * 128, MaskNone(), l);
        CTX_DONE();
    }
    for (;;) { int j; Q_NEXT(3, N_NA, j);
        const int rb = j % NA_BLK, h = (j / NA_BLK) & 3, b = j / (NA_BLK * 4);
        const int r0 = rb * 4;
        auto rstart = [](int r) { int s = r - 4; return s < 0 ? 0 : (s > IMG_ROWS - 8 ? IMG_ROWS - 8 : s); };
        const int rlo = rstart(r0), rhi = rstart(r0 + 3) + 7;
        float* bias = (float*)(lds + AttnLds<1, 64>::TOTAL);
        __syncthreads();
        for (int e = TID(); e < 15 * 31; e += NTHREADS) bias[e] = p.sm(OFF_S_RPB)[((size_t)l * 4 + h) * 15 * 31 + e] * LOG2E;
        const int wave = TID() >> 6, lane = TID() & 63;
        const int rq = r0 + (wave >> 1), cq = (wave & 1) * 32 + (lane & 31);
        MaskNA mk{bias, rq, cq, rstart(rq), rlo};
        attn_item<1, 64>(p, lds, b * S + r0 * 64, 256, LC + (rhi - rlo + 1), KTokNA{b, rlo}, C_QN + h * 64, C_KN + h * 64, C_VN + h * 64, 768 + h * 64, mk, l);
    }
    if (need_ctx) for (;;) { int j; Q_NEXT(4, N_NAC, j);
        const int h = j & 3, b = j >> 2;
        attn_item<1, 64>(p, lds, NL + b * L, L, LC, KTokCtx{b}, C_QN + h * 64, C_KN + h * 64, C_VN + h * 64, 768 + h * 64, MaskNone(), l);
        CTX_DONE();
    }
    if (need_ctx) for (;;) { int j; Q_NEXT(6, (NC / 256) * (D / 256), j);
        if (TID() == 0) {
            unsigned sp = 0;
            while (atomicAdd(ctxdone, 0) < N_GLA + N_DIFFC + N_NAC) {
#ifdef EMU
                sched_yield();
#else
                __builtin_amdgcn_s_sleep(16);
#endif
                if (++sp > (1u << 24)) break;
            }
#ifndef EMU
            __builtin_amdgcn_fence(__ATOMIC_ACQUIRE, "agent");
            asm volatile("s_waitcnt vmcnt(0)" ::: "memory");
#endif
        }
        __syncthreads();
        OneUnitOrder S1; S1.pm = NL / 256 + j / (D / 256); S1.pn = j % (D / 256); S1.Bt = (const bf16_t*)(p.ws + OFF_WOUT) + (size_t)l * D * MIXW; S1.K = MIXW;
        EpiOut epi{(bf16_t*)(p.ws + OFF_XD), (const float*)(p.ws + OFF_MOD) + (size_t)l * (NB + 1) * 6 * D};
        g8::gemm_phase(lds, (const bf16_t*)(p.ws + OFF_MIX), MIXW, S1, epi);
    }
#undef CTX_DONE
#undef Q_NEXT
}

constexpr int cmax(int a, int b) { return a > b ? a : b; }
constexpr int LDS_BYTES = cmax(cmax(g8::STAGE_BYTES + 1024 + 8192, AttnLds<2, 128>::TOTAL), cmax(ROUTER_LDS, cmax(AttnLds<1, 64>::TOTAL + 2048, GLA_LDS))) + 16;

#ifndef MK_LAUNCHES
#define MK_LAUNCHES 1
#endif
template <int PT> __device__ __forceinline__ void run_phase(const Params& pin, int l, char* lds) {
    PP p; p.ws = pin.ws; p.out = pin.out; p.x = (PT == 1 || PT == 7 || PT == 10) ? pin.x : nullptr; p.ctx = (PT == 1 || PT == 7 || PT == 10) ? pin.ctx : nullptr;
    LAUNDER_GPTR(p.ws); LAUNDER_GPTR(p.out); LAUNDER_S(l);
    if (PT == 0) phase_prologue(pin, lds);
    if (PT == 1) phase_norm<0>(p, l, lds);
    if (PT == 2) phase_gemm_in(p, l, lds);
    if (PT == 5) { phase_mixers(p, l, lds); cvt_ahead(pin, l, lds); }
    if (PT == 6) phase_gemm_out(p, l, lds);
    if (PT == 7) phase_router(p, l, lds);
    if (PT == 8) phase_moe<1>(p, l, lds);
    if (PT == 9) phase_moe<0>(p, l, lds);
    if (PT == 10) phase_norm<2>(p, 0, lds);
}
template <int PT> __global__ void __launch_bounds__(NTHREADS, 2) k_phase(Params p, int l) {
    DYN_LDS(lds_raw);
    run_phase<PT>(p, l, lds_raw + 16);
}

#if MK_LAUNCHES == 1
__global__ void __launch_bounds__(NTHREADS, 2) mega(Params p) {
    DYN_LDS(lds_raw);
    char* lds = lds_raw + 16;
#ifdef EMU
    GridBar gb{(unsigned*)(p.ws + OFF_BAR)};
#else
    if (threadIdx.x == 0) *(uint4*)lds_raw = make_uint4(0u, 0u, 0u, 0u);
    __syncthreads();
    GridBar gb = xcd_barrier_post((unsigned*)(p.ws + OFF_BAR), (volatile LAS unsigned*)lds_raw);
#endif
    run_phase<0>(p, 0, lds); grid_barrier(gb);
    for (int l = 0; l < DEPTH; ++l) {
        run_phase<1>(p, l, lds); grid_barrier(gb);
        run_phase<2>(p, l, lds); grid_barrier(gb);
        run_phase<5>(p, l, lds); grid_barrier(gb);
        run_phase<6>(p, l, lds); grid_barrier(gb);
        run_phase<7>(p, l, lds); grid_barrier(gb);
        run_phase<8>(p, l, lds); grid_barrier(gb);
        run_phase<9>(p, l, lds); grid_barrier(gb);
    }
    run_phase<10>(p, 0, lds);
}
#endif


extern "C" void kernel_launch(void* const* d_in, const int* in_sizes, int n_in, void* d_out, int out_size, void* d_ws, size_t ws_size, hipStream_t stream) {
    (void)in_sizes; (void)n_in; (void)out_size; (void)ws_size;
    Params p;
    p.x = (const float*)d_in[0]; p.c = (const float*)d_in[1]; p.ctx = (const float*)d_in[2]; p.c_ctx = (const float*)d_in[3];
    p.w_mod = (const float*)d_in[4]; p.b_mod = (const float*)d_in[5]; p.g1 = (const float*)d_in[6]; p.g2 = (const float*)d_in[7];
    p.w_in = (const float*)d_in[8]; p.w_out = (const float*)d_in[9]; p.lam = (const float*)d_in[10]; p.g_sub = (const float*)d_in[11];
    p.w_dec = (const float*)d_in[12]; p.b_dec = (const float*)d_in[13]; p.g_gla = (const float*)d_in[14]; p.rpb = (const float*)d_in[15];
    p.w_rg = (const float*)d_in[16]; p.b_rg = (const float*)d_in[17]; p.w_re = (const float*)d_in[18]; p.b_re = (const float*)d_in[19];
    p.w_up = (const float*)d_in[20]; p.w_dn = (const float*)d_in[21]; p.g_fin = (const float*)d_in[22];
    p.out = (float*)d_out; p.ws = (char*)d_ws;
    (void)hipMemsetAsync(d_ws, 0, ZERO_BYTES, stream);
#ifdef EMU
    const int grid = emu::g_max_os_threads;
#define LAUNCH_PH(PT, l) do { auto t0 = std::chrono::steady_clock::now(); EMU_LAUNCH(k_phase<PT>, grid, NTHREADS, LDS_BYTES, stream, p, l); \
        fprintf(stderr, "  phase type %d layer %d: %.2f s\n", PT, l, std::chrono::duration<double>(std::chrono::steady_clock::now() - t0).count()); } while (0)
#if MK_LAUNCHES == 1
#define LAUNCH_MEGA() EMU_LAUNCH(mega, grid, NTHREADS, LDS_BYTES, stream, p)
#else
#define LAUNCH_MEGA() do {} while (0)
#endif
    const int hi = getenv("EMU_PH_HI") ? atoi(getenv("EMU_PH_HI")) : 1000;
#else
    static int grid = 0;
    if (!grid) {
        int dev = 0, cus = 0, per_cu = 0;
        (void)hipGetDevice(&dev);
        (void)hipDeviceGetAttribute(&cus, hipDeviceAttributeMultiprocessorCount, dev);
#if MK_LAUNCHES == 1
        (void)hipFuncSetAttribute((const void*)mega, hipFuncAttributeMaxDynamicSharedMemorySize, LDS_BYTES);
#endif
#if MK_LAUNCHES == 0
        (void)hipFuncSetAttribute((const void*)k_phase<0>, hipFuncAttributeMaxDynamicSharedMemorySize, LDS_BYTES);
        (void)hipFuncSetAttribute((const void*)k_phase<1>, hipFuncAttributeMaxDynamicSharedMemorySize, LDS_BYTES);
        (void)hipFuncSetAttribute((const void*)k_phase<2>, hipFuncAttributeMaxDynamicSharedMemorySize, LDS_BYTES);
        (void)hipFuncSetAttribute((const void*)k_phase<3>, hipFuncAttributeMaxDynamicSharedMemorySize, LDS_BYTES);
        (void)hipFuncSetAttribute((const void*)k_phase<4>, hipFuncAttributeMaxDynamicSharedMemorySize, LDS_BYTES);
        (void)hipFuncSetAttribute((const void*)k_phase<5>, hipFuncAttributeMaxDynamicSharedMemorySize, LDS_BYTES);
        (void)hipFuncSetAttribute((const void*)k_phase<6>, hipFuncAttributeMaxDynamicSharedMemorySize, LDS_BYTES);
        (void)hipFuncSetAttribute((const void*)k_phase<7>, hipFuncAttributeMaxDynamicSharedMemorySize, LDS_BYTES);
        (void)hipFuncSetAttribute((const void*)k_phase<8>, hipFuncAttributeMaxDynamicSharedMemorySize, LDS_BYTES);
        (void)hipFuncSetAttribute((const void*)k_phase<9>, hipFuncAttributeMaxDynamicSharedMemorySize, LDS_BYTES);
        (void)hipFuncSetAttribute((const void*)k_phase<10>, hipFuncAttributeMaxDynamicSharedMemorySize, LDS_BYTES);
        (void)hipOccupancyMaxActiveBlocksPerMultiprocessor(&per_cu, k_phase<5>, NTHREADS, LDS_BYTES);
#else
        (void)hipOccupancyMaxActiveBlocksPerMultiprocessor(&per_cu, mega, NTHREADS, LDS_BYTES);
#endif
        grid = cus * (per_cu < 1 ? per_cu : 1);
        if (grid <= 0) grid = cus;
    }
#define LAUNCH_PH(PT, l) hipLaunchKernelGGL(k_phase<PT>, dim3(grid), dim3(NTHREADS), LDS_BYTES, stream, p, l)
#if MK_LAUNCHES == 1
#define LAUNCH_MEGA() hipLaunchKernelGGL(mega, dim3(grid), dim3(NTHREADS), LDS_BYTES, stream, p)
#else
#define LAUNCH_MEGA() do {} while (0)
#endif
    const int hi = 1000;
#endif
#if MK_LAUNCHES == 1
    (void)hi; LAUNCH_MEGA();
#else
    {
        int ph = 0;
#define STEP(PT, l) do { if (ph++ < hi) LAUNCH_PH(PT, l); } while (0)
        STEP(0, 0);
        for (int l = 0; l < DEPTH; ++l) { STEP(1, l); STEP(2, l); STEP(5, l); STEP(6, l); STEP(7, l); STEP(8, l); STEP(9, l); }
        STEP(10, 0);
    }
#endif
}

#ifdef EMU
#include <string>
static void dump_file(const std::string& path, const void* ptr, size_t bytes) { FILE* f = fopen(path.c_str(), "wb"); fwrite(ptr, 1, bytes, f); fclose(f); }
extern "C" void emu_debug_dump(void* d_ws, const char* dir) {
    char* ws = (char*)d_ws; std::string d(dir);
    dump_file(d + "/ws_X.bin", ws + OFF_X, (size_t)NT * D * 4);
    dump_file(d + "/ws_H.bin", ws + OFF_H, (size_t)NT * D * 2);
    dump_file(d + "/ws_P.bin", ws + OFF_P, (size_t)NT * PW * 2);
    dump_file(d + "/ws_MIX.bin", ws + OFF_MIX, (size_t)NT * MIXW * 2);
    dump_file(d + "/ws_MOD.bin", ws + OFF_MOD, (size_t)DEPTH * (NB + 1) * 6 * D * 4);
    dump_file(d + "/ws_ROUTE.bin", ws + OFF_ROUTE, (size_t)NT * 32);
}
#endif
```
